# Optimizing an MI355X kernel written in HIP

```python
import math
import jax, jax.numpy as jnp
from jax import lax
import numpy as np

D_MODEL = 1024
BATCH = 4
SEQ = 4096
DEPTH = 4
DEC_BATCH = 128
DEC_SEQ = 4
PAST_LEN = 8192
PAGE_SIZE = 128

N_MIXERS = 3
N_A_LAYERS = (DEPTH + 2) // 3
N_B_LAYERS = (DEPTH + 1) // 3
N_C_LAYERS = DEPTH // 3
D_FF = 4 * D_MODEL
EPS = 1e-6
NEG_INF = -1e30

A_CHUNK = 128
A_D_FFN = 6 * D_MODEL
A_HALF = A_D_FFN // 2
A_GROUPS = 8
A_GROUP_W = A_HALF // A_GROUPS

B_HEADS = 16
B_KV_HEADS = 4
B_HEAD_DIM = 64
B_WINDOW = 128
B_BLOCK = 128
N_BUCKETS = 32
MAX_DISTANCE = 128

C_D_INNER = 2 * D_MODEL
C_HEAD_DIM = 64
C_HEADS = C_D_INNER // C_HEAD_DIM
C_GROUPS = 4
C_D_STATE = 128
C_D_CONV = 4
C_CONV_DIM = C_D_INNER + 2 * C_GROUPS * C_D_STATE
C_IN_DIM = C_D_INNER + C_CONV_DIM + C_HEADS
C_CHUNK = 128

kernel_name = "hybrid_gmlp_swa_ssd_step"


def rmsnorm(x, g):
    xf = x.astype(jnp.float32)
    y = xf * lax.rsqrt(jnp.mean(xf * xf, axis=-1, keepdims=True) + EPS)
    return (y * g.astype(jnp.float32)).astype(x.dtype)


def sq_relu_mlp(x, w_up, w_down):
    h = jax.nn.relu(x @ w_up)
    return (h * h) @ w_down


def chunk_mlp_mixer(x, w_in, norm_v, w_sp, b_sp, w_out, chunk):
    b, L, _ = x.shape
    nc = L // chunk
    uv = jax.nn.gelu(x @ w_in, approximate=False)
    u, v = jnp.split(uv, 2, axis=-1)
    v = rmsnorm(v, norm_v)
    vg = v.reshape(b, nc, chunk, A_GROUPS, A_GROUP_W)
    causal = jnp.tril(jnp.ones((chunk, chunk), dtype=bool))
    ws = jnp.where(causal[None], w_sp[:, :chunk, :chunk], 0).astype(v.dtype)
    bias = jnp.swapaxes(b_sp[:, :chunk], 0, 1)[None, None, :, :, None]
    s = jnp.einsum('gij,bcjgw->bcigw', ws, vg) + bias.astype(v.dtype)
    out = (u * s.reshape(b, L, A_HALF)) @ w_out
    return out, v


def t5_bucket(rel):
    max_exact = N_BUCKETS // 2
    n = jnp.maximum(rel, 0)
    nf = jnp.maximum(n, 1).astype(jnp.float32)
    large = max_exact + (jnp.log(nf / max_exact) / math.log(MAX_DISTANCE / max_exact)
                         * (N_BUCKETS - max_exact)).astype(jnp.int32)
    large = jnp.minimum(large, N_BUCKETS - 1)
    return jnp.where(n < max_exact, n, large)


def banded_attention(q, k, v, q_pos, k_pos, sinks, rel_bias):
    b, nb, Q, H, Dh = q.shape
    K = k.shape[2]
    R = H // B_KV_HEADS
    qg = q.reshape(b, nb, Q, B_KV_HEADS, R, Dh)
    logits = jnp.einsum('bnqgrd,bnkgd->bngrqk', qg, k).astype(jnp.float32) * (Dh ** -0.5)
    rel = q_pos[:, :, None] - k_pos[:, None, :]
    valid = (rel >= 0) & (rel < B_WINDOW) & (k_pos[:, None, :] >= 0)
    bias = rel_bias.astype(jnp.float32)[t5_bucket(rel)]
    bias = bias.reshape(nb, Q, K, B_KV_HEADS, R).transpose(0, 3, 4, 1, 2)
    logits = jnp.where(valid[:, None, None], logits + bias[None], NEG_INF)
    sink = jnp.broadcast_to(sinks.astype(jnp.float32).reshape(B_KV_HEADS, R)[None, None, :, :, None, None],
                            (b, nb, B_KV_HEADS, R, Q, 1))
    probs = jax.nn.softmax(jnp.concatenate([logits, sink], axis=-1), axis=-1)[..., :-1]
    out = jnp.einsum('bngrqk,bnkgd->bnqgrd', probs.astype(v.dtype), v)
    return out.reshape(b, nb * Q, H * Dh)


def swa_project(x, w_qkv, q_norm, k_norm):
    b, L, _ = x.shape
    qkv = x @ w_qkv
    q, k, v = jnp.split(qkv, [B_HEADS * B_HEAD_DIM, (B_HEADS + B_KV_HEADS) * B_HEAD_DIM], axis=-1)
    q = rmsnorm(q.reshape(b, L, B_HEADS, B_HEAD_DIM), q_norm)
    k = rmsnorm(k.reshape(b, L, B_KV_HEADS, B_HEAD_DIM), k_norm)
    v = v.reshape(b, L, B_KV_HEADS, B_HEAD_DIM)
    return q, k, v


def swa_prompt(x, w_qkv, q_norm, k_norm, sinks, rel_bias, w_out):
    b, L, _ = x.shape
    q, k, v = swa_project(x, w_qkv, q_norm, k_norm)
    nb = L // B_BLOCK
    qb = q.reshape(b, nb, B_BLOCK, B_HEADS, B_HEAD_DIM)
    kb = k.reshape(b, nb, B_BLOCK, B_KV_HEADS, B_HEAD_DIM)
    vb = v.reshape(b, nb, B_BLOCK, B_KV_HEADS, B_HEAD_DIM)
    kband = jnp.concatenate([jnp.concatenate([jnp.zeros_like(kb[:, :1]), kb[:, :-1]], axis=1), kb], axis=2)
    vband = jnp.concatenate([jnp.concatenate([jnp.zeros_like(vb[:, :1]), vb[:, :-1]], axis=1), vb], axis=2)
    q_pos = jnp.arange(L, dtype=jnp.int32).reshape(nb, B_BLOCK)
    k_pos = (jnp.arange(nb, dtype=jnp.int32)[:, None] - 1) * B_BLOCK + jnp.arange(2 * B_BLOCK, dtype=jnp.int32)[None, :]
    o = banded_attention(qb, kband, vband, q_pos, k_pos, sinks, rel_bias)
    keep = min(B_WINDOW, L)
    return o @ w_out, k[:, L - keep:], v[:, L - keep:]


def swa_sample(x, k_cache, v_cache, w_qkv, q_norm, k_norm, sinks, rel_bias, w_out):
    b, L, _ = x.shape
    q, k, v = swa_project(x, w_qkv, q_norm, k_norm)
    W = k_cache.shape[1]
    kk = jnp.concatenate([k_cache.astype(k.dtype), k], axis=1)
    vv = jnp.concatenate([v_cache.astype(v.dtype), v], axis=1)
    q_pos = (PAST_LEN + jnp.arange(L, dtype=jnp.int32))[None]
    k_pos = (PAST_LEN - W + jnp.arange(W + L, dtype=jnp.int32))[None]
    o = banded_attention(q[:, None], kk[:, None], vv[:, None], q_pos, k_pos, sinks, rel_bias)
    return o @ w_out, kk[:, L:], vv[:, L:]


def causal_conv(xbc, buf, w, bias):
    L = xbc.shape[1]
    xp = jnp.concatenate([buf.astype(xbc.dtype), xbc], axis=1)
    y = bias
    for tap in range(C_D_CONV):
        y = y + xp[:, tap:tap + L] * w[tap]
    return jax.nn.silu(y), xp[:, L:]


def ssd_scan(x, dt, A, Bm, Cm, h0, chunk):
    b, L, H, P = x.shape
    G, N = Bm.shape[2], Bm.shape[3]
    R = H // G
    nc = L // chunk
    f32 = jnp.float32
    xf = x.astype(f32).reshape(b, nc, chunk, G, R, P)
    dtc = dt.reshape(b, nc, chunk, G, R)
    Bc = Bm.astype(f32).reshape(b, nc, chunk, G, N)
    Cc = Cm.astype(f32).reshape(b, nc, chunk, G, N)
    acs = jnp.cumsum(dtc * A.reshape(G, R), axis=2)
    diff = acs[:, :, :, None] - acs[:, :, None]
    causal = jnp.tril(jnp.ones((chunk, chunk), dtype=bool))[:, :, None, None]
    decay = jnp.where(causal, jnp.exp(jnp.where(causal, diff, 0.0)), 0.0)
    cb = jnp.einsum('bcign,bcjgn->bcijg', Cc, Bc)
    w = cb[..., None] * decay * dtc[:, :, None]
    y_intra = jnp.einsum('bcijgr,bcjgrp->bcigrp', w, xf)
    decay_end = jnp.exp(acs[:, :, -1:] - acs)
    states = jnp.einsum('bcjgn,bcjgr,bcjgrp->bcgrpn', Bc, decay_end * dtc, xf)
    chunk_decay = jnp.exp(acs[:, :, -1])

    def step(h, inp):
        st, dec = inp
        return h * dec[..., None, None] + st, h

    h0g = h0.astype(f32).reshape(b, G, R, P, N)
    h_final, h_prev = lax.scan(step, h0g, (jnp.moveaxis(states, 1, 0), jnp.moveaxis(chunk_decay, 1, 0)))
    h_prev = jnp.moveaxis(h_prev, 0, 1)
    y_inter = jnp.einsum('bcign,bcgrpn,bcigr->bcigrp', Cc, h_prev, jnp.exp(acs))
    y = (y_intra + y_inter).reshape(b, L, H, P)
    return y, h_final.reshape(b, H, P, N)


def ssd_mixer(x, h0, conv_buf, w_in, conv_w, conv_b, dt_bias, a_log, d_skip, norm_w, w_out, chunk):
    b, L, _ = x.shape
    zxbcdt = x @ w_in
    z, xbc, dt = jnp.split(zxbcdt, [C_D_INNER, C_D_INNER + C_CONV_DIM], axis=-1)
    xbc_act, new_buf = causal_conv(xbc, conv_buf, conv_w, conv_b)
    xs, Bm, Cm = jnp.split(xbc_act, [C_D_INNER, C_D_INNER + C_GROUPS * C_D_STATE], axis=-1)
    xs = xs.reshape(b, L, C_HEADS, C_HEAD_DIM)
    Bm = Bm.reshape(b, L, C_GROUPS, C_D_STATE)
    Cm = Cm.reshape(b, L, C_GROUPS, C_D_STATE)
    dt = jax.nn.softplus(dt.astype(jnp.float32) + dt_bias.astype(jnp.float32))
    A = -jnp.exp(a_log.astype(jnp.float32))
    y, h = ssd_scan(xs, dt, A, Bm, Cm, h0, chunk)
    y = y + d_skip.astype(jnp.float32)[:, None] * xs.astype(jnp.float32)
    g = y.reshape(b, L, C_D_INNER) * jax.nn.silu(z.astype(jnp.float32))
    gg = g.reshape(b, L, C_GROUPS, C_D_INNER // C_GROUPS)
    gg = gg * lax.rsqrt(jnp.mean(gg * gg, axis=-1, keepdims=True) + EPS)
    y = (gg.reshape(b, L, C_D_INNER) * norm_w.astype(jnp.float32)).astype(x.dtype)
    return y @ w_out, h.astype(x.dtype), new_buf


def setup_inputs(seed: int = 0) -> dict:
    key = jax.random.key(seed)
    ks = iter(jax.random.split(key, 40))
    nrm = lambda shape, scale: jax.random.normal(next(ks), shape, jnp.float32) * scale
    win = min(B_WINDOW, PAST_LEN)
    dt0 = jnp.exp(jax.random.uniform(next(ks), (N_C_LAYERS, C_HEADS), jnp.float32, math.log(1e-3), math.log(1e-1)))
    return {
        "x_prompt": nrm((BATCH, SEQ, D_MODEL), 1.0),
        "x_sample": nrm((DEC_BATCH, DEC_SEQ, D_MODEL), 1.0),
        "cache_swa_k": nrm((N_B_LAYERS, DEC_BATCH, win, B_KV_HEADS, B_HEAD_DIM), 1.0),
        "cache_swa_v": nrm((N_B_LAYERS, DEC_BATCH, win, B_KV_HEADS, B_HEAD_DIM), 1.0),
        "state_ssm": nrm((N_C_LAYERS, DEC_BATCH, C_HEADS, C_HEAD_DIM, C_D_STATE), 0.1),
        "state_conv": nrm((N_C_LAYERS, DEC_BATCH, C_D_CONV - 1, C_CONV_DIM), 1.0),
        "norm_mixer": 1.0 + nrm((DEPTH, D_MODEL), 0.02),
        "norm_mlp": 1.0 + nrm((DEPTH, D_MODEL), 0.02),
        "mlp_w_up": nrm((DEPTH, D_MODEL, D_FF), D_MODEL ** -0.5),
        "mlp_w_down": nrm((DEPTH, D_FF, D_MODEL), D_FF ** -0.5),
        "a_w_in": nrm((N_A_LAYERS, D_MODEL, A_D_FFN), D_MODEL ** -0.5),
        "a_norm_v": 1.0 + nrm((N_A_LAYERS, A_HALF), 0.02),
        "a_w_spatial": nrm((N_A_LAYERS, A_GROUPS, A_CHUNK, A_CHUNK), 0.5 * A_CHUNK ** -0.5),
        "a_b_spatial": 1.0 + nrm((N_A_LAYERS, A_GROUPS, A_CHUNK), 0.1),
        "a_w_out": nrm((N_A_LAYERS, A_HALF, D_MODEL), A_HALF ** -0.5),
        "b_w_qkv": nrm((N_B_LAYERS, D_MODEL, (B_HEADS + 2 * B_KV_HEADS) * B_HEAD_DIM), D_MODEL ** -0.5),
        "b_q_norm": 1.0 + nrm((N_B_LAYERS, B_HEAD_DIM), 0.02),
        "b_k_norm": 1.0 + nrm((N_B_LAYERS, B_HEAD_DIM), 0.02),
        "b_sinks": nrm((N_B_LAYERS, B_HEADS), 0.5),
        "rel_bias": nrm((N_BUCKETS, B_HEADS), 0.5),
        "b_w_out": nrm((N_B_LAYERS, B_HEADS * B_HEAD_DIM, D_MODEL), (B_HEADS * B_HEAD_DIM) ** -0.5),
        "c_w_in": nrm((N_C_LAYERS, D_MODEL, C_IN_DIM), D_MODEL ** -0.5),
        "c_conv_w": nrm((N_C_LAYERS, C_D_CONV, C_CONV_DIM), C_D_CONV ** -0.5),
        "c_conv_b": nrm((N_C_LAYERS, C_CONV_DIM), 0.02),
        "c_dt_bias": dt0 + jnp.log(-jnp.expm1(-dt0)),
        "c_a_log": jnp.log(jax.random.uniform(next(ks), (N_C_LAYERS, C_HEADS), jnp.float32, 1.0, 16.0)),
        "c_d": 1.0 + nrm((N_C_LAYERS, C_HEADS), 0.02),
        "c_norm": 1.0 + nrm((N_C_LAYERS, C_D_INNER), 0.02),
        "c_w_out": nrm((N_C_LAYERS, C_D_INNER, D_MODEL), C_D_INNER ** -0.5),
    }


def reference(x_prompt, x_sample, cache_swa_k, cache_swa_v, state_ssm, state_conv,
              norm_mixer, norm_mlp, mlp_w_up, mlp_w_down,
              a_w_in, a_norm_v, a_w_spatial, a_b_spatial, a_w_out,
              b_w_qkv, b_q_norm, b_k_norm, b_sinks, rel_bias, b_w_out,
              c_w_in, c_conv_w, c_conv_b, c_dt_bias, c_a_log, c_d, c_norm, c_w_out):
    xp, xs = x_prompt, x_sample
    chunk_v_s = []
    swa_kp, swa_vp, swa_ks, swa_vs = [], [], [], []
    ssm_p, conv_p, ssm_s, conv_s = [], [], [], []
    for i in range(DEPTH):
        kind = i % N_MIXERS
        j = i // N_MIXERS
        hp = rmsnorm(xp, norm_mixer[i])
        hs = rmsnorm(xs, norm_mixer[i])
        if kind == 0:
            op, _ = chunk_mlp_mixer(hp, a_w_in[j], a_norm_v[j], a_w_spatial[j], a_b_spatial[j], a_w_out[j], A_CHUNK)
            os_, v_new = chunk_mlp_mixer(hs, a_w_in[j], a_norm_v[j], a_w_spatial[j], a_b_spatial[j], a_w_out[j], DEC_SEQ)
            chunk_v_s.append(v_new)
        elif kind == 1:
            op, kp, vp = swa_prompt(hp, b_w_qkv[j], b_q_norm[j], b_k_norm[j], b_sinks[j], rel_bias, b_w_out[j])
            os_, ks_, vs_ = swa_sample(hs, cache_swa_k[j], cache_swa_v[j], b_w_qkv[j], b_q_norm[j], b_k_norm[j],
                                       b_sinks[j], rel_bias, b_w_out[j])
            swa_kp.append(kp); swa_vp.append(vp); swa_ks.append(ks_); swa_vs.append(vs_)
        else:
            h0p = jnp.zeros((xp.shape[0], C_HEADS, C_HEAD_DIM, C_D_STATE), xp.dtype)
            bufp = jnp.zeros((xp.shape[0], C_D_CONV - 1, C_CONV_DIM), xp.dtype)
            op, hpn, bpn = ssd_mixer(hp, h0p, bufp, c_w_in[j], c_conv_w[j], c_conv_b[j], c_dt_bias[j],
                                     c_a_log[j], c_d[j], c_norm[j], c_w_out[j], C_CHUNK)
            os_, hsn, bsn = ssd_mixer(hs, state_ssm[j], state_conv[j], c_w_in[j], c_conv_w[j], c_conv_b[j],
                                      c_dt_bias[j], c_a_log[j], c_d[j], c_norm[j], c_w_out[j], DEC_SEQ)
            ssm_p.append(hpn); conv_p.append(bpn); ssm_s.append(hsn); conv_s.append(bsn)
        xp = xp + op
        xs = xs + os_
        xp = xp + sq_relu_mlp(rmsnorm(xp, norm_mlp[i]), mlp_w_up[i], mlp_w_down[i])
        xs = xs + sq_relu_mlp(rmsnorm(xs, norm_mlp[i]), mlp_w_up[i], mlp_w_down[i])
    return (xp, xs, jnp.stack(chunk_v_s),
            jnp.stack(swa_kp), jnp.stack(swa_vp), jnp.stack(swa_ks), jnp.stack(swa_vs),
            jnp.stack(ssm_p), jnp.stack(conv_p), jnp.stack(ssm_s), jnp.stack(conv_s))
```

```cpp
#include <hip/hip_runtime.h>
#include <cstdio>
#include <cstdint>
#ifndef SREP_UP
#define SREP_UP 0
#endif

#define LAS __attribute__((address_space(3)))
typedef unsigned short bf16_t;
typedef short bf16x8 __attribute__((ext_vector_type(8)));
typedef short s16x4 __attribute__((ext_vector_type(4)));
typedef short v4i16_t __attribute__((ext_vector_type(4)));
typedef float f32x4 __attribute__((ext_vector_type(4)));
typedef float f32x2 __attribute__((ext_vector_type(2)));
typedef unsigned u32x4 __attribute__((ext_vector_type(4)));
typedef unsigned u32x2 __attribute__((ext_vector_type(2)));
typedef __bf16 bf16v2_t __attribute__((ext_vector_type(2)));

constexpr int MP = 16384, MS = 512, MT = MP + MS;
constexpr int DM = 1024, FF = 4096, AFF = 6144, AH = 3072, NQKV = 1536, CIN = 5152, CINP = 5376, CDI = 2048, CXBC = 3072;
constexpr float EPS = 1e-6f;
enum { I_XP = 0, I_XS, I_CK, I_CV, I_SSM, I_CONV, I_NMIX, I_NMLP, I_WUP, I_WDN, I_AWIN, I_ANV, I_AWSP, I_ABSP, I_AWOUT, I_BQKV, I_BQN, I_BKN, I_BSINK, I_RELB, I_BWO,
       I_CWIN, I_CCW, I_CCB, I_CDTB, I_CALOG, I_CD, I_CNORM, I_CWO, N_IN };
constexpr size_t O_Y = 0, O_CV = 17301504, O_KP = 20447232, O_VP = 20578304, O_KS = 20709376, O_VS = 24903680, O_SSMP = 29097984, O_CONVP = 30146560,
                 O_SSMS = 30183424, O_CONVS = 63737856, O_TOTAL = 64917504;
constexpr size_t MiB = 1u << 20;
constexpr size_t WS_CTL = 0, WS_XSS = 1 * MiB, WS_VSS = 3 * MiB, WS_DT = 7 * MiB, WS_ACS = 10 * MiB, WS_CDEC = 13 * MiB, WS_GRS = 14 * MiB;
constexpr size_t WS_WUP = 16 * MiB, WS_WDN = 48 * MiB, WS_WAI = 80 * MiB, WS_WAO = 104 * MiB, WS_WQKV = 116 * MiB, WS_WBO = 119 * MiB, WS_WCI = 121 * MiB, WS_WCO = 132 * MiB;
constexpr size_t WS_XB = 136 * MiB;
constexpr size_t WS_UV = 170 * MiB, WS_GATED = 368 * MiB, WS_H = 170 * MiB, WS_QKV = 170 * MiB, WS_O = 368 * MiB;
constexpr size_t WS_Z = 170 * MiB, WS_XBCR = 236 * MiB, WS_HPREV = 236 * MiB, WS_XBCC = 336 * MiB, WS_CSAVE = 340 * MiB, WS_STATES = 360 * MiB, WS_YG = 436 * MiB;
constexpr size_t WS_NEED = 512 * MiB;

struct Args { const float* in[N_IN]; float* out; unsigned char* ws; int ph_lo, ph_hi; };

__device__ __forceinline__ float bf2f(unsigned h) { return __uint_as_float(h << 16); }
__device__ __forceinline__ unsigned pk2(float lo, float hi) { f32x2 v = {lo, hi}; bf16v2_t b = __builtin_convertvector(v, bf16v2_t); return __builtin_bit_cast(unsigned, b); }
__device__ __forceinline__ u32x2 pk4(f32x4 v) { u32x2 r; r.x = pk2(v[0], v[1]); r.y = pk2(v[2], v[3]); return r; }
__device__ __forceinline__ f32x4 unpk4(u32x2 w) { f32x4 r; r[0] = bf2f(w.x & 0xffffu); r[1] = bf2f(w.x >> 16); r[2] = bf2f(w.y & 0xffffu); r[3] = bf2f(w.y >> 16); return r; }
__device__ __forceinline__ float sq4(f32x4 a) { return (a[0] * a[0] + a[1] * a[1]) + (a[2] * a[2] + a[3] * a[3]); }
__device__ __forceinline__ u32x4 pk8(f32x4 a, f32x4 b) { u32x4 w; w.x = pk2(a[0], a[1]); w.y = pk2(a[2], a[3]); w.z = pk2(b[0], b[1]); w.w = pk2(b[2], b[3]); return w; }
__device__ __forceinline__ float silu_f(float x) { return x * __builtin_amdgcn_rcpf(1.0f + __builtin_amdgcn_exp2f(x * -1.4426950408889634f)); }
__device__ __forceinline__ float wave_sum(float v) {
#pragma unroll
    for (int o = 1; o < 64; o <<= 1) v += __shfl_xor(v, o);
    return v;
}
__device__ __forceinline__ float wave_max(float v) {
#pragma unroll
    for (int o = 1; o < 64; o <<= 1) v = fmaxf(v, __shfl_xor(v, o));
    return v;
}
template <class T> __device__ __forceinline__ T ntl(const T* p) { return __builtin_nontemporal_load(p); }
template <class T> __device__ __forceinline__ void nts(T v, T* p) { __builtin_nontemporal_store(v, p); }
#define LDS_WAIT() asm volatile("s_waitcnt lgkmcnt(0)" ::: "memory")
__device__ __forceinline__ s16x4 tr4(LAS const char* p) { return __builtin_bit_cast(s16x4, __builtin_amdgcn_ds_read_tr16_b64_v4i16((LAS v4i16_t*)p)); }
__device__ __forceinline__ bf16x8 tr_frag(LAS const char* tile, int pitch, int klo, int khi, int n0, int lane) {
    const int i = lane & 15, q = i >> 2, p = i & 3;
    const s16x4 lo = tr4(tile + (klo + q) * pitch + (n0 + 4 * p) * 2);
    const s16x4 hi = tr4(tile + (khi + q) * pitch + (n0 + 4 * p) * 2);
    return (bf16x8){lo[0], lo[1], lo[2], lo[3], hi[0], hi[1], hi[2], hi[3]};
}
__device__ __forceinline__ bf16x8 tr_frag_b(LAS const char* lb, int hi_off, int n0) {
    const s16x4 lo = tr4(lb + n0 * 2);
    const s16x4 hi = tr4(lb + hi_off + n0 * 2);
    return (bf16x8){lo[0], lo[1], lo[2], lo[3], hi[0], hi[1], hi[2], hi[3]};
}
#define TR_LANE_OFF(lane, pitch) ((((lane) & 15) >> 2) * (pitch) + ((lane) & 3) * 8)
#define MFMA16(a, b, c) __builtin_amdgcn_mfma_f32_16x16x32_bf16((a), (b), (c), 0, 0, 0)
namespace pg8 {
constexpr int BM = 256, BK = 64, HALF = 128, HTB = HALF * BK * 2  , STAGE_BYTES = 8 * HTB, NXCD = 8, WGM = 8;
__host__ __device__ __forceinline__ int lds_byte(int r, int c) { const int st = (r >> 4) * 2 + (c >> 5), rr = r & 15, cc = c & 31, ob = rr * 64 + cc * 2; return st * 1024 + (ob ^ (((ob >> 9) & 1) << 5)); }
__host__ __device__ __forceinline__ void stage_rc(int b, int& R, int& C) { const int st = b / 1024, sb = b % 1024, swz = sb ^ (((sb >> 9) & 1) << 5); R = (st >> 1) * 16 + swz / 64; C = (st & 1) * 32 + (swz % 64) / 2; }
__host__ __device__ __forceinline__ int perm32(int rho) { const int n = rho >> 4, i = rho & 15; return 8 * (i >> 2) + 4 * n + (i & 3); }

struct Unit { int pm, pn; };
struct Gemm { const bf16_t* A; const bf16_t* Bt; int M, N, K; };

struct StaticOrder {
    int nM, nN, nwg, G, c;
    __host__ __device__ void init(int M, int N, int G_, int c_) { nM = M / BM; nN = N / BM; nwg = nM * nN; G = G_; c = c_; }
    __host__ __device__ bool next(int i, Unit& u) const {
        const long L = (long)i * G + c; if (L >= nwg) return false;
        int wgid = (int)L; { const int q = nwg / NXCD, r = nwg % NXCD, xcd = wgid % NXCD, off = wgid / NXCD; wgid = (xcd < r ? xcd * (q + 1) : r * (q + 1) + (xcd - r) * q) + off; }
        const int nig = WGM * nN, gid = wgid / nig, fm = gid * WGM, gsz = (nM - fm) < WGM ? (nM - fm) : WGM;
        u.pm = fm + ((wgid % nig) % gsz); u.pn = (wgid % nig) / gsz; return true;
    }
    __device__ __forceinline__ void a_ready(const Unit&) const {}
    __device__ __forceinline__ void done(const Unit&) const {}
};

__device__ __forceinline__ f32x2 gelu_pk(f32x2 v) {
    const f32x2 av = __builtin_elementwise_abs(v), d = av * 0.2316418882f + 1.0f;
    f32x2 t; t.x = __builtin_amdgcn_rcpf(d.x); t.y = __builtin_amdgcn_rcpf(d.y);
    f32x2 q = t * 0.5307027145f + (-0.7265760135f); q = q * t + 0.7107068705f; q = q * t + (-0.142248368f); q = q * t + 0.127414796f; q = q * t;
    const f32x2 s = (v * v) * (-0.72134752044f);
    f32x2 e; e.x = __builtin_amdgcn_exp2f(s.x); e.y = __builtin_amdgcn_exp2f(s.y);
    const f32x2 m = v * (q * e), r = v - m;
    f32x2 o; o.x = v.x < 0.f ? m.x : r.x; o.y = v.y < 0.f ? m.y : r.y; return o;
}

template <class Epi, class Sched, bool ALIGN_EPI = false, bool SP2 = false>
__device__ __forceinline__ void gemm_phase(LAS unsigned char* lds, const Gemm g, const Sched& S, const Epi& E, const int tid) {
    const int wid = __builtin_amdgcn_readfirstlane(tid >> 6), lane = tid & 63, wr = wid >> 2, wc = wid & 3, fr = lane & 15, fq = lane >> 4;
    const int K = g.K, nt = K / BK;
    unsigned voffA[2], voffB[2];
#pragma unroll
    for (int i = 0; i < 2; ++i) { int R, C; stage_rc(tid * 16 + i * 8192, R, C);
        const int Rb = Epi::BMODE == 0 ? R : (Epi::BMODE == 1 ? ((R & ~31) + perm32(R & 31)) : (64 * (R >> 5) + perm32(R & 31)));
        voffA[i] = (unsigned)(R * K + C) * 2u; voffB[i] = (unsigned)(Rb * K + C) * 2u; }
    const size_t kstep = (size_t)(BK * 2);
    const size_t hstep = (size_t)HALF * K * 2;
    const size_t hstepB = (size_t)(Epi::BMODE == 2 ? 32 : HALF) * K * 2;
    const size_t tstep = 2 * hstep;
    const unsigned ldsw = (unsigned)wid * 1024u;
    const int aoff = lds_byte(wr * 64 + fr, fq * 8), boff = lds_byte(wc * 32 + fr, fq * 8);
#define PG8_SA(b, h) (((b) * 2 + (h)) * HTB)
#define PG8_SB(b, h) ((4 + (b) * 2 + (h)) * HTB)
#define PG8_STAGE(bufoff, gbase, voff) do { _Pragma("unroll") for (int _i = 0; _i < 2; ++_i) \
        __builtin_amdgcn_global_load_lds((const unsigned*)((const char*)(gbase) + (voff)[_i]), (LAS unsigned*)(lds + (bufoff) + ldsw + _i * 8192), 16, 0, 0); } while (0)
#define PG8_LDA(dst, b, h) do { _Pragma("unroll") for (int m = 0; m < 4; ++m) _Pragma("unroll") for (int k = 0; k < 2; ++k) dst[m][k] = *(const LAS bf16x8*)(lds + PG8_SA(b, h) + aoff + m * 2048 + k * 1024); } while (0)
#define PG8_LDB(dst, b, h) do { _Pragma("unroll") for (int n = 0; n < 2; ++n) _Pragma("unroll") for (int k = 0; k < 2; ++k) dst[n][k] = *(const LAS bf16x8*)(lds + PG8_SB(b, h) + boff + n * 2048 + k * 1024); } while (0)
#define PG8_MMA(ai, bj, At, Bt) do { __builtin_amdgcn_s_setprio(1); _Pragma("unroll") for (int m = 0; m < 4; ++m) _Pragma("unroll") for (int n = 0; n < 2; ++n) _Pragma("unroll") for (int k = 0; k < 2; ++k) \
        acc[ai][bj][m][n] = __builtin_amdgcn_mfma_f32_16x16x32_bf16(Bt[n][k], At[m][k], acc[ai][bj][m][n], 0, 0, 0); __builtin_amdgcn_s_setprio(0); } while (0)
#define PG8_WAIT_V(n) asm volatile("s_waitcnt vmcnt(" #n ")" ::: "memory")
#define PG8_WAIT_L(n) asm volatile("s_waitcnt lgkmcnt(" #n ")" ::: "memory")
#define PG8_BAR __builtin_amdgcn_s_barrier()
#define PG8_SCHED __builtin_amdgcn_sched_barrier(0)
    Unit cur, nxt; int ui = 0;
    if (!S.next(0, cur)) return;
    E.prepare(S, lds, tid);
    f32x4 acc[2][2][4][2];
#pragma unroll
    for (int a = 0; a < 2; ++a)
#pragma unroll
        for (int b = 0; b < 2; ++b)
#pragma unroll
            for (int m = 0; m < 4; ++m)
#pragma unroll
                for (int n = 0; n < 2; ++n) acc[a][b][m][n] = (f32x4){0.f, 0.f, 0.f, 0.f};
    bf16x8 At[4][2], B0[2][2], B1[2][2];
    const char* cA = (const char*)g.A + (size_t)cur.pm * tstep; const char* cB = (const char*)g.Bt + (size_t)cur.pn * tstep;
    S.a_ready(cur);
    if constexpr (SP2) {
        PG8_STAGE(PG8_SB(0, 0), cB, voffB); PG8_STAGE(PG8_SB(0, 1), cB + hstepB, voffB); PG8_STAGE(PG8_SA(0, 0), cA, voffA); PG8_STAGE(PG8_SA(0, 1), cA + hstep, voffA);
        if (wr == 1) PG8_BAR;
        PG8_WAIT_V(2); PG8_BAR;
        PG8_STAGE(PG8_SB(1, 0), cB + kstep, voffB); PG8_STAGE(PG8_SA(1, 0), cA + kstep, voffA); PG8_STAGE(PG8_SB(1, 1), cB + hstepB + kstep, voffB);
        PG8_WAIT_V(6); PG8_BAR;
    } else {
        PG8_STAGE(PG8_SB(0, 0), cB, voffB); PG8_STAGE(PG8_SA(0, 0), cA, voffA); PG8_STAGE(PG8_SB(0, 1), cB + hstepB, voffB); PG8_STAGE(PG8_SA(0, 1), cA + hstep, voffA);
        if (wr == 1) PG8_BAR;
        PG8_WAIT_V(4); PG8_BAR;
        PG8_STAGE(PG8_SB(1, 0), cB + kstep, voffB); PG8_STAGE(PG8_SA(1, 0), cA + kstep, voffA); PG8_STAGE(PG8_SB(1, 1), cB + hstepB + kstep, voffB);
        PG8_WAIT_V(6); PG8_BAR;
    }
    for (;;) {
        const bool has_next = S.next(ui + 1, nxt);
        const char* nA = has_next ? (const char*)g.A + (size_t)nxt.pm * tstep : cA; const char* nB = has_next ? (const char*)g.Bt + (size_t)nxt.pn * tstep : cB;
        for (int t = 0; t < nt; t += 2) {
            const bool last = (t == nt - 2);
            const char* a1 = cA + (size_t)(t + 1) * kstep;
            const char* a2 = last ? nA : cA + (size_t)(t + 2) * kstep; const char* b2 = last ? nB : cB + (size_t)(t + 2) * kstep;
            const char* a3 = a2 + kstep; const char* b3 = b2 + kstep;
            if (last && has_next) S.a_ready(nxt);
            if constexpr (SP2) {
            PG8_LDB(B0, 0, 0); PG8_LDB(B1, 0, 1); PG8_SCHED; PG8_LDA(At, 0, 0); PG8_STAGE(PG8_SA(1, 1), a1 + hstep, voffA);
            PG8_WAIT_V(8); PG8_WAIT_L(0); PG8_BAR; PG8_MMA(0, 0, At, B0); PG8_MMA(0, 1, At, B1); PG8_BAR; PG8_SCHED;
            PG8_LDA(At, 0, 1); PG8_STAGE(PG8_SB(0, 0), b2, voffB); PG8_STAGE(PG8_SB(0, 1), b2 + hstepB, voffB); PG8_STAGE(PG8_SA(0, 0), a2, voffA);
            PG8_WAIT_V(8); PG8_WAIT_L(0); PG8_BAR; PG8_MMA(1, 0, At, B0); PG8_MMA(1, 1, At, B1); PG8_BAR; PG8_SCHED;
            PG8_LDB(B0, 1, 0); PG8_LDB(B1, 1, 1); PG8_SCHED; PG8_LDA(At, 1, 0); PG8_STAGE(PG8_SA(0, 1), a2 + hstep, voffA);
            PG8_WAIT_V(8); PG8_WAIT_L(0); PG8_BAR; PG8_MMA(0, 0, At, B0); PG8_MMA(0, 1, At, B1); PG8_BAR; PG8_SCHED;
            PG8_LDA(At, 1, 1); PG8_STAGE(PG8_SB(1, 0), b3, voffB); PG8_STAGE(PG8_SB(1, 1), b3 + hstepB, voffB); PG8_STAGE(PG8_SA(1, 0), a3, voffA);
            PG8_WAIT_V(8); PG8_WAIT_L(0); PG8_BAR; PG8_MMA(1, 0, At, B0); PG8_MMA(1, 1, At, B1); PG8_BAR; PG8_SCHED;
            } else {
            PG8_LDB(B0, 0, 0); PG8_SCHED; PG8_LDA(At, 0, 0); PG8_STAGE(PG8_SA(1, 1), a1 + hstep, voffA);
            PG8_WAIT_L(8); PG8_BAR; PG8_WAIT_L(0); PG8_MMA(0, 0, At, B0); PG8_BAR; PG8_SCHED;
            PG8_LDB(B1, 0, 1); PG8_STAGE(PG8_SB(0, 0), b2, voffB);
            PG8_BAR; PG8_WAIT_L(0); PG8_MMA(0, 1, At, B1); PG8_BAR;
            PG8_LDA(At, 0, 1); PG8_STAGE(PG8_SA(0, 0), a2, voffA);
            PG8_BAR; PG8_WAIT_L(0); PG8_MMA(1, 0, At, B0); PG8_BAR; PG8_SCHED;
            PG8_STAGE(PG8_SB(0, 1), b2 + hstepB, voffB);
            PG8_WAIT_V(6); PG8_BAR; PG8_MMA(1, 1, At, B1); PG8_BAR;
            PG8_LDB(B0, 1, 0); PG8_SCHED; PG8_LDA(At, 1, 0); PG8_STAGE(PG8_SA(0, 1), a2 + hstep, voffA);
            PG8_WAIT_L(8); PG8_BAR; PG8_WAIT_L(0); PG8_MMA(0, 0, At, B0); PG8_BAR; PG8_SCHED;
            PG8_LDB(B1, 1, 1); PG8_STAGE(PG8_SB(1, 0), b3, voffB);
            PG8_BAR; PG8_WAIT_L(0); PG8_MMA(0, 1, At, B1); PG8_BAR;
            PG8_LDA(At, 1, 1); PG8_STAGE(PG8_SA(1, 0), a3, voffA);
            PG8_BAR; PG8_WAIT_L(0); PG8_MMA(1, 0, At, B0); PG8_BAR; PG8_SCHED;
            PG8_STAGE(PG8_SB(1, 1), b3 + hstepB, voffB);
            PG8_WAIT_V(6); PG8_BAR; PG8_MMA(1, 1, At, B1); PG8_BAR;
            }
            if constexpr (Epi::KSCALE) { if (((t + 2) & 7) == 0 && t + 2 < nt) E.kscale(acc, ((t + 2) >> 3) - 1, ui, lds, wr, fr); }
        }
        if constexpr (ALIGN_EPI) { if (wr == 0) PG8_BAR; }
        E(acc, cur, wr, wc, fr, fq, ui, lds); S.done(cur);
        if (!has_next) break;
#pragma unroll
        for (int a = 0; a < 2; ++a)
#pragma unroll
            for (int b = 0; b < 2; ++b)
#pragma unroll
                for (int m = 0; m < 4; ++m)
#pragma unroll
                    for (int n = 0; n < 2; ++n) acc[a][b][m][n] = (f32x4){0.f, 0.f, 0.f, 0.f};
        cur = nxt; cA = nA; cB = nB; ++ui;
        if constexpr (ALIGN_EPI) { if (wr == 1) PG8_BAR; }
    }
    PG8_WAIT_V(0);
    if constexpr (!ALIGN_EPI) { if (wr == 0) PG8_BAR; }
    PG8_BAR;
#undef PG8_SA
#undef PG8_SB
#undef PG8_STAGE
#undef PG8_LDA
#undef PG8_LDB
#undef PG8_MMA
#undef PG8_WAIT_V
#undef PG8_WAIT_L
#undef PG8_BAR
#undef PG8_SCHED
}

typedef f32x4 AccT[2][2][4][2];
constexpr int RS_OFF = 131072;
template <class Sched> __device__ __forceinline__ void rs_prepare(const float* XSS, const Sched& S, LAS unsigned char* lds, int tid) {
    LAS float* rsL = (LAS float*)(lds + RS_OFF); Unit u;
    int n = 0; while (S.next(n, u)) ++n;
    f32x4 v[3][4];
#pragma unroll
    for (int k = 0; k < 3; ++k) { const int idx = tid + 512 * k;
        if (idx < n * 256) { S.next(idx >> 8, u); const f32x4* p = (const f32x4*)(XSS + (size_t)(u.pm * BM + (idx & 255)) * 16); v[k][0] = p[0]; v[k][1] = p[1]; v[k][2] = p[2]; v[k][3] = p[3]; } }
#pragma unroll
    for (int k = 0; k < 3; ++k) { const int idx = tid + 512 * k;
        if (idx < n * 256) { const f32x4 a = v[k][0], b = v[k][1], c = v[k][2], d = v[k][3];
            const float s = ((a[0] + a[1]) + (a[2] + a[3])) + ((b[0] + b[1]) + (b[2] + b[3])) + ((c[0] + c[1]) + (c[2] + c[3])) + ((d[0] + d[1]) + (d[2] + d[3]));
            rsL[idx] = rsqrtf(s * (1.0f / 1024.0f) + EPS); } }
    asm volatile("s_waitcnt lgkmcnt(0)" ::: "memory"); __builtin_amdgcn_s_barrier(); asm volatile("" ::: "memory");
}
__device__ __forceinline__ void rs_get(LAS unsigned char* lds, int ui, int wr, int fr, float (&rs)[2][4]) {
    const LAS float* rsL = (const LAS float*)(lds + RS_OFF) + ui * 256 + wr * 64 + fr;
#pragma unroll
    for (int ai = 0; ai < 2; ++ai)
#pragma unroll
        for (int m = 0; m < 4; ++m) rs[ai][m] = rsL[ai * HALF + m * 16];
}
__device__ __forceinline__ void row_scales(const float* XSS, int row0, int fq, float (&rs)[2][4]) {
#pragma unroll
    for (int ai = 0; ai < 2; ++ai)
#pragma unroll
        for (int m = 0; m < 4; ++m) {
            const f32x4 v = *(const f32x4*)(XSS + (size_t)(row0 + ai * HALF + m * 16) * 16 + 4 * fq);
            float s = (v[0] + v[1]) + (v[2] + v[3]); s += __shfl_xor(s, 16); s += __shfl_xor(s, 32);
            rs[ai][m] = rsqrtf(s * (1.0f / 1024.0f) + EPS);
        }
}

struct EpiAIn {
    static constexpr bool KSCALE = false;
    template <class Sched> __device__ __forceinline__ void prepare(const Sched& S, LAS unsigned char* lds, int tid) const { rs_prepare(XSS, S, lds, tid); }
    static constexpr int BMODE = 1;
    bf16_t* UV; const float* XSS; float* VSS;
    __device__ __forceinline__ void operator()(const AccT& acc, const Unit& u, int wr, int wc, int fr, int fq, int ui, LAS unsigned char* lds) const {
        const int row0 = u.pm * BM + wr * 64 + fr, col0 = u.pn * BM + wc * 32 + 8 * fq;
        float rs[2][4]; rs_get(lds, ui, wr, fr, rs);
        const bool isv = u.pn >= 12;
#pragma unroll
        for (int ai = 0; ai < 2; ++ai)
#pragma unroll
            for (int m = 0; m < 4; ++m) { const int row = row0 + ai * HALF + m * 16; float ss = 0.f; const float r = rs[ai][m];
#pragma unroll
                for (int bj = 0; bj < 2; ++bj) { f32x4 v0 = acc[ai][bj][m][0] * r, v1 = acc[ai][bj][m][1] * r;
                    const f32x2 a = gelu_pk((f32x2){v0[0], v0[1]}), b = gelu_pk((f32x2){v0[2], v0[3]}), c = gelu_pk((f32x2){v1[0], v1[1]}), d = gelu_pk((f32x2){v1[2], v1[3]});
                    v0 = (f32x4){a.x, a.y, b.x, b.y}; v1 = (f32x4){c.x, c.y, d.x, d.y};
                    ss += sq4(v0) + sq4(v1);
                    *(u32x4*)(UV + (size_t)row * AFF + col0 + bj * HALF) = pk8(v0, v1); }
                if (isv) { ss += __shfl_xor(ss, 16); ss += __shfl_xor(ss, 32); if (fq == 0) VSS[(size_t)row * 48 + (u.pn - 12) * 4 + wc] = ss; } }
    }
};
template <bool WITHG> struct EpiResT {
    static constexpr bool KSCALE = WITHG;
    template <class Sched> __device__ __forceinline__ void prepare(const Sched& S, LAS unsigned char* lds, int tid) const {
        if (!WITHG) return;
        LAS float* tb = (LAS float*)(lds + RS_OFF); Unit u;
        for (int i = 0; S.next(i, u); ++i) if (tid < 256) { const f32x4 q = *(const f32x4*)(GRS + (size_t)(u.pm * BM + tid) * 4);
            tb[(i * 4 + 0) * 256 + tid] = q[0] / q[1]; tb[(i * 4 + 1) * 256 + tid] = q[1] / q[2]; tb[(i * 4 + 2) * 256 + tid] = q[2] / q[3]; tb[(i * 4 + 3) * 256 + tid] = q[3]; }
        asm volatile("s_waitcnt lgkmcnt(0)" ::: "memory"); __builtin_amdgcn_s_barrier(); asm volatile("" ::: "memory");
    }
    __device__ __forceinline__ void kscale(AccT& acc, int gdone, int ui, LAS unsigned char* lds, int wr, int fr) const {
        if (!WITHG) return;
        const LAS float* tb = (const LAS float*)(lds + RS_OFF) + (ui * 4 + gdone) * 256 + wr * 64 + fr;
#pragma unroll
        for (int ai = 0; ai < 2; ++ai)
#pragma unroll
            for (int m = 0; m < 4; ++m) { const float f = tb[ai * HALF + m * 16];
#pragma unroll
                for (int bj = 0; bj < 2; ++bj)
#pragma unroll
                    for (int n = 0; n < 2; ++n) acc[ai][bj][m][n] = acc[ai][bj][m][n] * f; }
    }
    static constexpr int BMODE = 1;
    float* Y; unsigned char* ws; const float* GRS;
    __device__ __forceinline__ void operator()(const AccT& acc, const Unit& u, int wr, int wc, int fr, int fq, int ui, LAS unsigned char* lds) const {
        const int row0 = u.pm * BM + wr * 64 + fr, col0 = u.pn * BM + wc * 32 + 8 * fq;
        bf16_t* XB = (bf16_t*)(ws + WS_XB); float* XSS = (float*)(ws + WS_XSS);
        const LAS float* tb = (const LAS float*)(lds + RS_OFF) + (ui * 4 + 3) * 256 + wr * 64 + fr;
#pragma unroll
        for (int ai = 0; ai < 2; ++ai)
#pragma unroll
            for (int m = 0; m < 4; ++m) { const int row = row0 + ai * HALF + m * 16; float ss = 0.f; const size_t off = (size_t)row * DM + col0;
                const float fs = WITHG ? tb[ai * HALF + m * 16] : 1.0f;
#pragma unroll
                for (int bj = 0; bj < 2; ++bj) {
                    const u32x4 o = *(const u32x4*)(XB + off + bj * HALF);
                    const f32x4 n0 = unpk4((u32x2){o.x, o.y}) + acc[ai][bj][m][0] * fs, n1 = unpk4((u32x2){o.z, o.w}) + acc[ai][bj][m][1] * fs;
                    *(u32x4*)(XB + off + bj * HALF) = pk8(n0, n1);
                    if (Y) { nts(n0, (f32x4*)(Y + off + bj * HALF)); nts(n1, (f32x4*)(Y + off + bj * HALF + 4)); }
                    ss += sq4(n0) + sq4(n1); }
                ss += __shfl_xor(ss, 16); ss += __shfl_xor(ss, 32); if (fq == 0) XSS[(size_t)row * 16 + u.pn * 4 + wc] = ss;
                asm volatile("" ::: "memory"); }
    }
};
typedef EpiResT<false> EpiRes;
typedef EpiResT<true> EpiResG;
struct EpiUp {
    static constexpr bool KSCALE = false;
    template <class Sched> __device__ __forceinline__ void prepare(const Sched& S, LAS unsigned char* lds, int tid) const { rs_prepare(XSS, S, lds, tid); }
    static constexpr int BMODE = 1;
    bf16_t* H; const float* XSS;
    __device__ __forceinline__ void operator()(const AccT& acc, const Unit& u, int wr, int wc, int fr, int fq, int ui, LAS unsigned char* lds) const {
        const int row0 = u.pm * BM + wr * 64 + fr, col0 = u.pn * BM + wc * 32 + 8 * fq;
        float rs[2][4]; rs_get(lds, ui, wr, fr, rs);
#pragma unroll
        for (int ai = 0; ai < 2; ++ai)
#pragma unroll
            for (int m = 0; m < 4; ++m) { const int row = row0 + ai * HALF + m * 16; const float r = rs[ai][m];
#pragma unroll
                for (int bj = 0; bj < 2; ++bj) { f32x4 v0 = acc[ai][bj][m][0] * r, v1 = acc[ai][bj][m][1] * r;
#pragma unroll
                    for (int e = 0; e < 4; ++e) { const float a = fmaxf(v0[e], 0.f), b = fmaxf(v1[e], 0.f); v0[e] = a * a; v1[e] = b * b; }
                    *(u32x4*)(H + (size_t)row * FF + col0 + bj * HALF) = pk8(v0, v1);
                    } }
    }
};
struct EpiQKV {
    static constexpr bool KSCALE = false;
    template <class Sched> __device__ __forceinline__ void prepare(const Sched& S, LAS unsigned char* lds, int tid) const { rs_prepare(XSS, S, lds, tid); }
    static constexpr int BMODE = 2;
    bf16_t* QKV; const float* XSS; const float* qn; const float* kn;
    __device__ __forceinline__ void operator()(const AccT& acc, const Unit& u, int wr, int wc, int fr, int fq, int ui, LAS unsigned char* lds) const {
        const int row0 = u.pm * BM + wr * 64 + fr, colh = u.pn * BM + wc * 64;
        float rs[2][4]; rs_get(lds, ui, wr, fr, rs);
        const float* nw = (u.pn < 4) ? qn : kn; const bool donorm = u.pn < 5;
        f32x4 w[2][2];
#pragma unroll
        for (int bj = 0; bj < 2; ++bj)
#pragma unroll
            for (int n = 0; n < 2; ++n) w[bj][n] = donorm ? *(const f32x4*)(nw + bj * 32 + 8 * fq + 4 * n) : (f32x4){1.f, 1.f, 1.f, 1.f};
#pragma unroll
        for (int ai = 0; ai < 2; ++ai)
#pragma unroll
            for (int m = 0; m < 4; ++m) { const int row = row0 + ai * HALF + m * 16; const float r = rs[ai][m];
                f32x4 v[2][2]; float ss = 0.f;
#pragma unroll
                for (int bj = 0; bj < 2; ++bj)
#pragma unroll
                    for (int n = 0; n < 2; ++n) { v[bj][n] = acc[ai][bj][m][n] * r; ss += sq4(v[bj][n]); }
                ss += __shfl_xor(ss, 16); ss += __shfl_xor(ss, 32);
                const float hs = donorm ? rsqrtf(ss * (1.0f / 64.0f) + EPS) : 1.0f;
#pragma unroll
                for (int bj = 0; bj < 2; ++bj)
                    *(u32x4*)(QKV + (size_t)row * NQKV + colh + bj * 32 + 8 * fq) = pk8(v[bj][0] * hs * w[bj][0], v[bj][1] * hs * w[bj][1]); }
    }
};
struct EpiCIn {
    static constexpr bool KSCALE = false;
    template <class Sched> __device__ __forceinline__ void prepare(const Sched& S, LAS unsigned char* lds, int tid) const { rs_prepare(XSS, S, lds, tid); }
    static constexpr int BMODE = 1;
    bf16_t* Z; bf16_t* XBCR; float* DT; const float* XSS; const float* dtb;
    __device__ __forceinline__ void operator()(const AccT& acc, const Unit& u, int wr, int wc, int fr, int fq, int ui, LAS unsigned char* lds) const {
        const int row0 = u.pm * BM + wr * 64 + fr;
        float rs[2][4]; rs_get(lds, ui, wr, fr, rs);
        if (u.pn < 20) {
            bf16_t* base; int ld, col0;
            if (u.pn < 8) { base = Z; ld = CDI; col0 = u.pn * BM + wc * 32 + 8 * fq; } else { base = XBCR; ld = CXBC; col0 = (u.pn - 8) * BM + wc * 32 + 8 * fq; }
#pragma unroll
            for (int ai = 0; ai < 2; ++ai)
#pragma unroll
                for (int m = 0; m < 4; ++m) { const int row = row0 + ai * HALF + m * 16; const float r = rs[ai][m];
#pragma unroll
                    for (int bj = 0; bj < 2; ++bj) *(u32x4*)(base + (size_t)row * ld + col0 + bj * HALF) = pk8(acc[ai][bj][m][0] * r, acc[ai][bj][m][1] * r); }
        } else if (wc == 0) {
            const f32x4 b0 = *(const f32x4*)(dtb + 8 * fq), b1 = *(const f32x4*)(dtb + 8 * fq + 4);
#pragma unroll
            for (int ai = 0; ai < 2; ++ai)
#pragma unroll
                for (int m = 0; m < 4; ++m) { const int row = row0 + ai * HALF + m * 16; const float r = rs[ai][m];
                    f32x4 v0 = acc[ai][0][m][0] * r + b0, v1 = acc[ai][0][m][1] * r + b1;
#pragma unroll
                    for (int e = 0; e < 4; ++e) { v0[e] = v0[e] > 20.f ? v0[e] : log1pf(__expf(v0[e])); v1[e] = v1[e] > 20.f ? v1[e] : log1pf(__expf(v1[e])); }
                    *(f32x4*)(DT + (size_t)row * 32 + 8 * fq) = v0; *(f32x4*)(DT + (size_t)row * 32 + 8 * fq + 4) = v1; }
        }
    }
};
}
namespace sg {
template <class Epi>
__device__ __forceinline__ void sgemm_phase(LAS char* lds, const bf16_t* A, const bf16_t* Bt, int N, int K, int ncols_used, const Epi& E, int tid, int bid, int G, int k_lo, int k_hi, int n_extra = 0, int extra_strip = 0, int mode = 0) {
    const int lane = tid & 63, w = __builtin_amdgcn_readfirstlane(tid >> 6), fr = lane & 15, fq = lane >> 4;
    const int nstrip = ncols_used / 64, Kw = K / 8, nbat = Kw / 64;
    LAS float* red = (LAS float*)lds;
    const unsigned lo = (unsigned)(fr * K + 8 * fq) * 2u, rstep = (unsigned)K * 32u;
    const int xq = bid & 7, jq = bid >> 3, S = nstrip >> 3;
    auto decode = [&](int k, int& row0, int& strip) -> bool {
        if (k >= k_hi) return false;
        int e;
        if (G == 256) {
            int nk;
            if (mode == 0) { nk = (S - (jq & 3) + 3) >> 2; if (k < nk) { row0 = MP + 64 * (jq >> 2); strip = xq * S + (jq & 3) + 4 * k; return true; } }
            else { const int jj = jq - 16; nk = jj < 0 ? 0 : (S - (jj & 1) + 1) >> 1; if (k < nk) { row0 = MP + 64 * (jj >> 1); strip = xq * S + (jj & 1) + 2 * k; return true; } }
            const int ke = k - nk; e = ke == 0 ? bid : (ke == 1 && jq == 3 ? G + xq : n_extra);
        } else {
            const int u = (G - 1 - bid) + k * G, nsamp = 8 * nstrip;
            if (u < nsamp) { row0 = MP + 64 * (u & 7); strip = u >> 3; return true; }
            e = u - nsamp;
        }
        if (e >= n_extra) return false;
        row0 = e < MP / 64 ? 64 * e : MP + 64 * (e - MP / 64); strip = extra_strip; return true;
    };
    bf16x8 a0[2][4], b0[2][4], a1[2][4], b1[2][4];
#define SG_LOAD(fa, fb, kb) do { _Pragma("unroll") for (int s = 0; s < 2; ++s) { _Pragma("unroll") for (int m = 0; m < 4; ++m) fa[s][m] = *(const bf16x8*)(Au + (size_t)(m * rstep) + (size_t)lo + ((kb) + 32 * s) * 2); \
            _Pragma("unroll") for (int n = 0; n < 4; ++n) fb[s][n] = *(const bf16x8*)(Bu + (size_t)(n * rstep) + (size_t)lo + ((kb) + 32 * s) * 2); } } while (0)
#define SG_MMA(fa, fb) do { _Pragma("unroll") for (int s = 0; s < 2; ++s) _Pragma("unroll") for (int m = 0; m < 4; ++m) _Pragma("unroll") for (int n = 0; n < 4; ++n) acc[m][n] = MFMA16(fb[s][n], fa[s][m], acc[m][n]); } while (0)
#define SG_BASES(r0, sp) const char* Au = (const char*)A + ((size_t)(r0) * K + (size_t)w * Kw) * 2; const char* Bu = (const char*)Bt + ((size_t)(64 * (sp)) * K + (size_t)w * Kw) * 2
    int k = k_lo, rowb = 0, st = 0; bool have = decode(k, rowb, st);
    if (have) { SG_BASES(rowb, st); SG_LOAD(a0, b0, 0); }
    while (have) {
        const int erow = rowb + (tid >> 3); float pre = E.pre(erow); f32x4 pl0, pl1; E.preload(erow, 64 * st + (tid & 7) * 8, pl0, pl1);
        f32x4 acc[4][4];
#pragma unroll
        for (int m = 0; m < 4; ++m)
#pragma unroll
            for (int n = 0; n < 4; ++n) acc[m][n] = (f32x4){0.f, 0.f, 0.f, 0.f};
        { SG_BASES(rowb, st);
          for (int b = 0; b < nbat; b += 2) {
            SG_LOAD(a1, b1, 64 * (b + 1));
            SG_MMA(a0, b0);
            if (b + 2 < nbat) SG_LOAD(a0, b0, 64 * (b + 2));
            SG_MMA(a1, b1);
          } }
        asm volatile("" : "+v"(pre), "+v"(pl0), "+v"(pl1));
        int rown = 0, stn = 0; const bool haven = decode(k + 1, rown, stn);
        if (haven) { SG_BASES(rown, stn); SG_LOAD(a0, b0, 0); }
#pragma unroll
        for (int m = 0; m < 4; ++m) { const float f = E.wscale(rowb + 16 * m + fr, w);
#pragma unroll
            for (int n = 0; n < 4; ++n) acc[m][n] = acc[m][n] * f; }
#pragma unroll
        for (int m = 0; m < 4; ++m)
#pragma unroll
            for (int n = 0; n < 4; ++n) *(LAS f32x4*)(red + (w * 64 + 16 * m + fr) * 68 + 16 * n + 4 * fq) = acc[m][n];
        __syncthreads();
        { const int row = tid >> 3, c8 = (tid & 7) * 8; f32x4 s0 = (f32x4){0.f, 0.f, 0.f, 0.f}, s1 = s0;
#pragma unroll
          for (int ww = 0; ww < 8; ++ww) { s0 += *(const LAS f32x4*)(red + (ww * 64 + row) * 68 + c8); s1 += *(const LAS f32x4*)(red + (ww * 64 + row) * 68 + c8 + 4); }
          E.apply(erow, 64 * st + c8, s0, s1, pre, pl0, pl1); }
        __syncthreads();
        ++k; rowb = rown; st = stn; have = haven;
    }
#undef SG_LOAD
#undef SG_MMA
#undef SG_BASES
}
template <class Epi>
__device__ __forceinline__ void sgemm32_phase(LAS char* lds, const bf16_t* A, const bf16_t* Bt, int K, const Epi& E, int tid, int bid, int G, int k_lo, int k_hi) {
    const int lane = tid & 63, w = __builtin_amdgcn_readfirstlane(tid >> 6), fr = lane & 15, fq = lane >> 4;
    const int nunit = 16 * (DM / 64), Kw = K / 8, nbat = Kw / 64;
    LAS float* red = (LAS float*)lds;
    const unsigned lo = (unsigned)(fr * K + 8 * fq) * 2u, rstep = (unsigned)K * 32u;
    bf16x8 a0[2][2], b0[2][4], a1[2][2], b1[2][4], a2[2][2], b2[2][4];
#define SG_LOAD(fa, fb, kb) do { _Pragma("unroll") for (int s = 0; s < 2; ++s) { _Pragma("unroll") for (int m = 0; m < 2; ++m) fa[s][m] = *(const bf16x8*)(Au + (size_t)(m * rstep) + (size_t)lo + ((kb) + 32 * s) * 2); \
            _Pragma("unroll") for (int n = 0; n < 4; ++n) fb[s][n] = *(const bf16x8*)(Bu + (size_t)(n * rstep) + (size_t)lo + ((kb) + 32 * s) * 2); } } while (0)
#define SG_MMA(fa, fb) do { _Pragma("unroll") for (int s = 0; s < 2; ++s) _Pragma("unroll") for (int m = 0; m < 2; ++m) _Pragma("unroll") for (int n = 0; n < 4; ++n) acc[m][n] = MFMA16(fb[s][n], fa[s][m], acc[m][n]); } while (0)
#define SG_BASES(uu) const char* Au = (const char*)A + ((size_t)(MP + 32 * ((uu) & 15)) * K + (size_t)w * Kw) * 2; const char* Bu = (const char*)Bt + ((size_t)(64 * ((uu) >> 4)) * K + (size_t)w * Kw) * 2
    if (G == 256) { const int xq = bid & 7, jq = bid >> 3; bid = 16 * (4 * (xq & 3) + (jq & 3)) + 8 * (xq >> 2) + (jq >> 2); } else bid = G - 1 - bid;
    int u = bid + k_lo * G; const int uend = (bid + k_hi * G < nunit ? bid + k_hi * G : nunit);
    if (u < uend) { SG_BASES(u); SG_LOAD(a0, b0, 0); SG_LOAD(a1, b1, 64); }
    while (u < uend) {
        const int rowb = MP + 32 * (u & 15), st = u >> 4;
        const int erow = rowb + ((tid >> 3) & 31); f32x4 pl0, pl1; E.preload(erow, 64 * st + (tid & 7) * 8, pl0, pl1);
        f32x4 acc[2][4];
#pragma unroll
        for (int m = 0; m < 2; ++m)
#pragma unroll
            for (int n = 0; n < 4; ++n) acc[m][n] = (f32x4){0.f, 0.f, 0.f, 0.f};
        { SG_BASES(u);
          for (int b = 0; b < nbat; b += 3) {
            if (b + 2 < nbat) SG_LOAD(a2, b2, 64 * (b + 2));
            SG_MMA(a0, b0);
            if (b + 1 < nbat) { if (b + 3 < nbat) SG_LOAD(a0, b0, 64 * (b + 3)); SG_MMA(a1, b1); }
            if (b + 2 < nbat) { if (b + 4 < nbat) SG_LOAD(a1, b1, 64 * (b + 4)); SG_MMA(a2, b2); }
          } }
        asm volatile("" : "+v"(pl0), "+v"(pl1));
        const int un = u + G;
        if (un < uend) { SG_BASES(un); SG_LOAD(a0, b0, 0); SG_LOAD(a1, b1, 64); }
#pragma unroll
        for (int m = 0; m < 2; ++m) { const float f = E.wscale(rowb + 16 * m + fr, w);
#pragma unroll
            for (int n = 0; n < 4; ++n) *(LAS f32x4*)(red + (w * 32 + 16 * m + fr) * 68 + 16 * n + 4 * fq) = acc[m][n] * f; }
        __syncthreads();
        if (tid < 256) { const int row = tid >> 3, c8 = (tid & 7) * 8; f32x4 s0 = (f32x4){0.f, 0.f, 0.f, 0.f}, s1 = s0;
#pragma unroll
          for (int ww = 0; ww < 8; ++ww) { s0 += *(const LAS f32x4*)(red + (ww * 32 + row) * 68 + c8); s1 += *(const LAS f32x4*)(red + (ww * 32 + row) * 68 + c8 + 4); }
          E.apply(erow, 64 * st + c8, s0, s1, 0.f, pl0, pl1); }
        __syncthreads();
        u = un;
    }
#undef SG_LOAD
#undef SG_MMA
#undef SG_BASES
}
__device__ __forceinline__ float row8_sum(float v) { v += __shfl_xor(v, 1); v += __shfl_xor(v, 2); v += __shfl_xor(v, 4); return v; }
__device__ __forceinline__ float xss_scale(const float* XSS, int row) {
    const f32x4* p = (const f32x4*)(XSS + (size_t)row * 16); const f32x4 a = p[0], b = p[1], c = p[2], d = p[3];
    const float s = ((a[0] + a[1]) + (a[2] + a[3])) + ((b[0] + b[1]) + (b[2] + b[3])) + ((c[0] + c[1]) + (c[2] + c[3])) + ((d[0] + d[1]) + (d[2] + d[3]));
    return rsqrtf(s * (1.0f / 1024.0f) + EPS);
}
struct SEpiAIn { bf16_t* UV; const float* XSS; float* VSS;
    __device__ __forceinline__ float pre(int row) const { return xss_scale(XSS, row); }
    __device__ __forceinline__ float wscale(int, int) const { return 1.0f; }
    __device__ __forceinline__ void preload(int, int, f32x4& p0, f32x4& p1) const { p0 = p1 = (f32x4){0.f, 0.f, 0.f, 0.f}; }
    __device__ __forceinline__ void apply(int row, int col0, f32x4 s0, f32x4 s1, float r, f32x4, f32x4) const {
        s0 = s0 * r; s1 = s1 * r;
        const f32x2 a = pg8::gelu_pk((f32x2){s0[0], s0[1]}), b = pg8::gelu_pk((f32x2){s0[2], s0[3]}), c = pg8::gelu_pk((f32x2){s1[0], s1[1]}), d = pg8::gelu_pk((f32x2){s1[2], s1[3]});
        s0 = (f32x4){a.x, a.y, b.x, b.y}; s1 = (f32x4){c.x, c.y, d.x, d.y};
        *(u32x4*)(UV + (size_t)row * AFF + col0) = pk8(s0, s1);
        if (col0 >= AH) { const float ss = row8_sum(sq4(s0) + sq4(s1)); if ((threadIdx.x & 7) == 0) VSS[(size_t)row * 48 + (col0 - AH) / 64] = ss; } }
};
template <bool WITHG> struct SEpiResT { float* Y; unsigned char* ws; const float* GRS;
    __device__ __forceinline__ float pre(int) const { return 0.f; }
    __device__ __forceinline__ float wscale(int row, int w) const { return WITHG ? GRS[(size_t)row * 4 + (w >> 1)] : 1.0f; }
    __device__ __forceinline__ void preload(int row, int col0, f32x4& p0, f32x4& p1) const { p0 = *(const f32x4*)((const bf16_t*)(ws + WS_XB) + (size_t)row * DM + col0); p1 = (f32x4){0.f, 0.f, 0.f, 0.f}; }
    __device__ __forceinline__ void apply(int row, int col0, f32x4 s0, f32x4 s1, float, f32x4 p0, f32x4) const {
        bf16_t* xp = (bf16_t*)(ws + WS_XB) + (size_t)row * DM + col0; const u32x4 o = __builtin_bit_cast(u32x4, p0);
        const f32x4 n0 = unpk4((u32x2){o.x, o.y}) + s0, n1 = unpk4((u32x2){o.z, o.w}) + s1;
        *(u32x4*)xp = pk8(n0, n1);
        if (Y) { float* yp = Y + (size_t)row * DM + col0; *(f32x4*)yp = n0; *(f32x4*)(yp + 4) = n1; }
        const float ss = row8_sum(sq4(n0) + sq4(n1)); if ((threadIdx.x & 7) == 0) ((float*)(ws + WS_XSS))[(size_t)row * 16 + col0 / 64] = ss; }
};
typedef SEpiResT<false> SEpiRes;
typedef SEpiResT<true> SEpiResG;
struct SEpiUp { bf16_t* H; const float* XSS;
    __device__ __forceinline__ float pre(int row) const { return xss_scale(XSS, row); }
    __device__ __forceinline__ float wscale(int, int) const { return 1.0f; }
    __device__ __forceinline__ void preload(int, int, f32x4& p0, f32x4& p1) const { p0 = p1 = (f32x4){0.f, 0.f, 0.f, 0.f}; }
    __device__ __forceinline__ void apply(int row, int col0, f32x4 s0, f32x4 s1, float r, f32x4, f32x4) const {
#pragma unroll
        for (int e = 0; e < 4; ++e) { const float a = fmaxf(s0[e] * r, 0.f), b = fmaxf(s1[e] * r, 0.f); s0[e] = a * a; s1[e] = b * b; }
        *(u32x4*)(H + (size_t)row * FF + col0) = pk8(s0, s1); }
};
struct SEpiQKV { bf16_t* QKV; const float* XSS; const float* qn; const float* kn;
    __device__ __forceinline__ float pre(int row) const { return xss_scale(XSS, row); }
    __device__ __forceinline__ float wscale(int, int) const { return 1.0f; }
    __device__ __forceinline__ void preload(int, int col0, f32x4& p0, f32x4& p1) const { const float* nw = (col0 < 1024 ? qn : kn) + (col0 & 63); p0 = *(const f32x4*)nw; p1 = *(const f32x4*)(nw + 4); }
    __device__ __forceinline__ void apply(int row, int col0, f32x4 s0, f32x4 s1, float r, f32x4 p0, f32x4 p1) const {
        s0 = s0 * r; s1 = s1 * r;
        if (col0 < 1280) { const float ss = row8_sum(sq4(s0) + sq4(s1)); const float hs = rsqrtf(ss * (1.0f / 64.0f) + EPS);
            s0 = s0 * hs * p0; s1 = s1 * hs * p1; }
        *(u32x4*)(QKV + (size_t)row * NQKV + col0) = pk8(s0, s1); }
};
struct SEpiCIn { bf16_t* Z; bf16_t* XBCR; float* DT; const float* XSS; const float* dtb;
    __device__ __forceinline__ float pre(int row) const { return xss_scale(XSS, row); }
    __device__ __forceinline__ float wscale(int, int) const { return 1.0f; }
    __device__ __forceinline__ void preload(int, int, f32x4& p0, f32x4& p1) const { p0 = p1 = (f32x4){0.f, 0.f, 0.f, 0.f}; }
    __device__ __forceinline__ void apply(int row, int col0, f32x4 s0, f32x4 s1, float r, f32x4, f32x4) const {
        s0 = s0 * r; s1 = s1 * r;
        if (col0 < CDI) *(u32x4*)(Z + (size_t)row * CDI + col0) = pk8(s0, s1);
        else if (col0 < CDI + CXBC) *(u32x4*)(XBCR + (size_t)row * CXBC + col0 - CDI) = pk8(s0, s1);
        else if (col0 < CIN) { const int c = col0 - (CDI + CXBC); s0 += *(const f32x4*)(dtb + c); s1 += *(const f32x4*)(dtb + c + 4);
#pragma unroll
            for (int e = 0; e < 4; ++e) { s0[e] = s0[e] > 20.f ? s0[e] : log1pf(__expf(s0[e])); s1[e] = s1[e] > 20.f ? s1[e] : log1pf(__expf(s1[e])); }
            *(f32x4*)(DT + (size_t)row * 32 + c) = s0; *(f32x4*)(DT + (size_t)row * 32 + c + 4) = s1; } }
};
}
typedef __attribute__((address_space(1))) const float* gfp_t;
typedef __attribute__((address_space(4))) const gfp_t* tab_t;
struct Ctx {
    LAS char* lds; int tid, lane, wave, fr, fq, G, bid;
    tab_t in; float* out; unsigned char* ws;
};
__device__ __forceinline__ Ctx ctx_local(const Ctx& C0) { Ctx C = C0; int t = C0.tid; asm volatile("" : "+v"(t)); C.tid = t; C.lane = t & 63; C.wave = __builtin_amdgcn_readfirstlane(t >> 6); C.fr = C.lane & 15; C.fq = C.lane >> 4; return C; }
#define WSP(T, off) ((T*)(C.ws + (off)))
#define GASP(T, p) ((T*)(__attribute__((address_space(1))) T*)(p))
#define GIN(i) ((const float*)C.in[i])

__device__ __forceinline__ void wt_item(const float* W, int K, int N, const float* g, bf16_t* WT, LAS float* scr, int item, int lane) {
    const int nblk = N / 32, kb = item / nblk, nb = item % nblk, k0 = 64 * kb, n0 = 32 * nb;
#pragma unroll 8
    for (int i = 0; i < 32; ++i) { const int kk = 2 * i + (lane >> 5); const float s = g ? g[k0 + kk] : 1.0f; scr[kk * 33 + (lane & 31)] = W[(size_t)(k0 + kk) * N + n0 + (lane & 31)] * s; }
    LDS_WAIT(); asm volatile("" ::: "memory");
    const int c = lane & 7;
#pragma unroll
    for (int j = 0; j < 4; ++j) { const int n = (lane >> 3) + 8 * j; const LAS float* s = scr + (8 * c) * 33 + n;
        u32x4 o; o.x = pk2(s[0 * 33], s[1 * 33]); o.y = pk2(s[2 * 33], s[3 * 33]); o.z = pk2(s[4 * 33], s[5 * 33]); o.w = pk2(s[6 * 33], s[7 * 33]);
        *(u32x4*)(WT + (size_t)(n0 + n) * K + k0 + 8 * c) = o; }
    LDS_WAIT(); asm volatile("" ::: "memory");
}
__device__ __forceinline__ void wt_item64(const float* W, int K, int N, const float* g, bf16_t* WT, LAS char* scr, int item, int lane) {
    const int nblk = N / 64, kb = item / nblk, nb = item % nblk, k0 = 64 * kb, n0 = 64 * nb;
    const int krow = lane >> 4, n4 = (lane & 15) * 4;
    f32x4 v[16];
#pragma unroll
    for (int i = 0; i < 16; ++i) v[i] = *(const f32x4*)(W + (size_t)(k0 + 4 * i + krow) * N + n0 + n4);
#pragma unroll
    for (int i = 0; i < 16; ++i) { const float s = g ? g[k0 + 4 * i + krow] : 1.0f; *(LAS u32x2*)(scr + (4 * i + krow) * 144 + n4 * 2) = pk4(v[i] * s); }
    LDS_WAIT(); asm volatile("" ::: "memory");
    const int g4 = lane >> 4, i16 = lane & 15, q = i16 >> 2, p = i16 & 3;
#pragma unroll
    for (int nbk = 0; nbk < 4; ++nbk)
#pragma unroll
        for (int kh = 0; kh < 2; ++kh) { const int kk = 32 * kh + 8 * g4;
            const s16x4 lo = tr4(scr + (kk + q) * 144 + (16 * nbk + 4 * p) * 2), hi = tr4(scr + (kk + 4 + q) * 144 + (16 * nbk + 4 * p) * 2);
            u32x4 o; o.x = (unsigned)(unsigned short)lo[0] | ((unsigned)(unsigned short)lo[1] << 16); o.y = (unsigned)(unsigned short)lo[2] | ((unsigned)(unsigned short)lo[3] << 16);
            o.z = (unsigned)(unsigned short)hi[0] | ((unsigned)(unsigned short)hi[1] << 16); o.w = (unsigned)(unsigned short)hi[2] | ((unsigned)(unsigned short)hi[3] << 16);
            *(u32x4*)(WT + (size_t)(n0 + 16 * nbk + i16) * K + k0 + kk) = o; }
    LDS_WAIT(); asm volatile("" ::: "memory");
}
struct WtJob { const float* W; const float* g; bf16_t* WT; int K, N, k0, n0; };
__device__ __forceinline__ WtJob wt_decode(const Ctx& C, int it) {
    constexpr int I_UP = 16 * 64, I_DN = 64 * 16, I_AI = 16 * 96, I_AO = 48 * 16, I_QKV = 16 * 24, I_BO = 16 * 16, I_CI = 16 * 81, I_CO = 32 * 16;
    WtJob j; int r = it, nblk;
    if (r < 4 * I_UP) { const int L = r / I_UP; r -= L * I_UP; j.W = GIN(I_WUP) + (size_t)L * DM * FF; j.g = GIN(I_NMLP) + L * DM; j.WT = WSP(bf16_t, WS_WUP) + (size_t)L * FF * DM; j.K = DM; j.N = FF; }
    else if ((r -= 4 * I_UP) < 4 * I_DN) { const int L = r / I_DN; r -= L * I_DN; j.W = GIN(I_WDN) + (size_t)L * FF * DM; j.g = nullptr; j.WT = WSP(bf16_t, WS_WDN) + (size_t)L * DM * FF; j.K = FF; j.N = DM; }
    else if ((r -= 4 * I_DN) < 2 * I_AI) { const int L = r / I_AI; r -= L * I_AI; j.W = GIN(I_AWIN) + (size_t)L * DM * AFF; j.g = GIN(I_NMIX) + (L * 3) * DM; j.WT = WSP(bf16_t, WS_WAI) + (size_t)L * AFF * DM; j.K = DM; j.N = AFF; }
    else if ((r -= 2 * I_AI) < 2 * I_AO) { const int L = r / I_AO; r -= L * I_AO; j.W = GIN(I_AWOUT) + (size_t)L * AH * DM; j.g = nullptr; j.WT = WSP(bf16_t, WS_WAO) + (size_t)L * DM * AH; j.K = AH; j.N = DM; }
    else if ((r -= 2 * I_AO) < I_QKV) { j.W = GIN(I_BQKV); j.g = GIN(I_NMIX) + 1 * DM; j.WT = WSP(bf16_t, WS_WQKV); j.K = DM; j.N = NQKV; }
    else if ((r -= I_QKV) < I_BO) { j.W = GIN(I_BWO); j.g = nullptr; j.WT = WSP(bf16_t, WS_WBO); j.K = DM; j.N = DM; }
    else if ((r -= I_BO) < I_CI) { j.W = GIN(I_CWIN); j.g = GIN(I_NMIX) + 2 * DM; j.WT = WSP(bf16_t, WS_WCI); j.K = DM; j.N = CIN; }
    else { r -= I_CI; j.W = GIN(I_CWO); j.g = GIN(I_CNORM); j.WT = WSP(bf16_t, WS_WCO); j.K = CDI; j.N = DM; }
    nblk = (j.N + 63) / 64; j.k0 = 64 * (r / nblk); j.n0 = 64 * (r % nblk); return j;
}
__device__ __forceinline__ void wt_load(const WtJob& j, int lane, f32x4 (&v)[16]) {
    const int krow = lane >> 4, n = j.n0 + (lane & 15) * 4;
#pragma unroll
    for (int i = 0; i < 16; ++i) { v[i] = (f32x4){0.f, 0.f, 0.f, 0.f}; if (n < j.N) { v[i] = ntl((const f32x4*)(j.W + (size_t)(j.k0 + 4 * i + krow) * j.N + n)); if (j.g) v[i] = v[i] * j.g[j.k0 + 4 * i + krow]; } }
}
__device__ __forceinline__ void phase_prologue(const Ctx& C0) {
    const Ctx C = ctx_local(C0);
    LAS char* scr = C.lds + C.wave * 16384;
    const int gw = C.bid * 8 + C.wave, NGW = C.G * 8, lane = C.lane;
    constexpr int NIT = 4 * 16 * 64 + 4 * 64 * 16 + 2 * 16 * 96 + 2 * 48 * 16 + 16 * 24 + 16 * 16 + 16 * 81 + 32 * 16;
    {
        f32x4 v[16]; WtJob cur;
        if (gw < NIT) { cur = wt_decode(C, gw); wt_load(cur, lane, v); }
        for (int it = gw; it < NIT; it += NGW) {
            const int krow = lane >> 4, n4 = (lane & 15) * 4;
#pragma unroll
            for (int i = 0; i < 16; ++i) *(LAS u32x2*)(scr + (4 * i + krow) * 144 + n4 * 2) = pk4(v[i]);
            const WtJob job = cur;
            if (it + NGW < NIT) { cur = wt_decode(C, it + NGW); wt_load(cur, lane, v); }
            LDS_WAIT(); asm volatile("" ::: "memory");
            const int g4 = lane >> 4, i16 = lane & 15, q = i16 >> 2, p = i16 & 3;
#pragma unroll
            for (int nbk = 0; nbk < 4; ++nbk) if (job.n0 + 16 * nbk < job.N) {
#pragma unroll
                for (int kh = 0; kh < 2; ++kh) { const int kk = 32 * kh + 8 * g4;
                    const s16x4 lo = tr4(scr + (kk + q) * 144 + (16 * nbk + 4 * p) * 2), hi = tr4(scr + (kk + 4 + q) * 144 + (16 * nbk + 4 * p) * 2);
                    u32x4 o; o.x = (unsigned)(unsigned short)lo[0] | ((unsigned)(unsigned short)lo[1] << 16); o.y = (unsigned)(unsigned short)lo[2] | ((unsigned)(unsigned short)lo[3] << 16);
                    o.z = (unsigned)(unsigned short)hi[0] | ((unsigned)(unsigned short)hi[1] << 16); o.w = (unsigned)(unsigned short)hi[2] | ((unsigned)(unsigned short)hi[3] << 16);
                    *(u32x4*)(job.WT + (size_t)(job.n0 + 16 * nbk + i16) * job.K + job.k0 + kk) = o; } }
            LDS_WAIT(); asm volatile("" ::: "memory");
        }
    }
    { u32x4* z = (u32x4*)(WSP(bf16_t, WS_WCI) + (size_t)CIN * DM); const int n16 = (CINP - CIN) * DM * 2 / 16;
      u32x4 zz = (u32x4){0u, 0u, 0u, 0u}; asm volatile("" : "+v"(zz));
      for (int i = C.bid * 512 + C.tid; i < n16; i += C.G * 512) z[i] = zz; }
    bf16_t* XB = WSP(bf16_t, WS_XB); float* XSS = WSP(float, WS_XSS);
    for (int m0 = 2 * gw; m0 < MT; m0 += 2 * NGW) {
        f32x4 v[2][4];
#pragma unroll
        for (int r = 0; r < 2; ++r) { const int m = m0 + r; const float* xr = (m < MP) ? GIN(I_XP) + (size_t)m * DM : GIN(I_XS) + (size_t)(m - MP) * DM;
#pragma unroll
            for (int j = 0; j < 4; ++j) v[r][j] = ntl((const f32x4*)xr + C.lane + 64 * j); }
#pragma unroll
        for (int r = 0; r < 2; ++r) { const int m = m0 + r;
            const float ss = wave_sum((sq4(v[r][0]) + sq4(v[r][1])) + (sq4(v[r][2]) + sq4(v[r][3])));
#pragma unroll
            for (int j = 0; j < 4; ++j) *((u32x2*)(XB + (size_t)m * DM) + C.lane + 64 * j) = pk4(v[r][j]);
            if (C.lane < 16) XSS[(size_t)m * 16 + C.lane] = (C.lane == 0) ? ss : 0.f; }
    }
}

__device__ __forceinline__ void phase_spatial(const Ctx& C0, int L) {
    const Ctx C = ctx_local(C0);
    const float* wsp = GIN(I_AWSP) + (size_t)L * 8 * 128 * 128; const float* bsp = GIN(I_ABSP) + L * 8 * 128; const float* nv = GIN(I_ANV) + L * AH;
    const bf16_t* UV = WSP(bf16_t, WS_UV); bf16_t* GT = WSP(bf16_t, WS_GATED); const float* VSS = WSP(float, WS_VSS);
    LAS char* Wt = C.lds; LAS char* Vt = C.lds + 34816; LAS float* rsv = (LAS float*)(C.lds + 34816 + 102400);
    const int w = C.wave, fr = C.fr, fq = C.fq, tid = C.tid;
    const int gq = C.bid & 7; const bool gfix = (C.G & 7) == 0;
    u32x4 vreg[12];
#define SP_LOADV(uu) do { const int g_ = (uu) & 7, c_ = (uu) >> 3; _Pragma("unroll") for (int v = 0; v < 12; ++v) { const int idx = tid + 512 * v, r = idx / 48, ch = idx % 48; \
        vreg[v] = *(const u32x4*)(UV + (size_t)(128 * c_ + r) * AFF + AH + 384 * g_ + 8 * ch); } } while (0)
#define SP_STAGEW(gg) do { const int i = tid >> 2, jq = (tid & 3) * 32; _Pragma("unroll") for (int v = 0; v < 8; ++v) { const int j0 = jq + 4 * v; const f32x4 wv = *(const f32x4*)(wsp + (size_t)((gg) * 128 + i) * 128 + j0); f32x4 o; \
        _Pragma("unroll") for (int e = 0; e < 4; ++e) o[e] = (j0 + e <= i) ? wv[e] : 0.f; *(LAS u32x2*)(Wt + i * 272 + j0 * 2) = pk4(o); } } while (0)
    if (gfix) SP_STAGEW(gq);
    if (C.bid < 1024) SP_LOADV(C.bid);
    for (int u = C.bid; u < 1024; u += C.G) {
        const int g = u & 7, c = u >> 3;
        if (tid < 128) { const f32x4* p = (const f32x4*)(VSS + (size_t)(128 * c + tid) * 48); float s = 0.f;
#pragma unroll
            for (int k = 0; k < 12; ++k) { const f32x4 t = p[k]; s += (t[0] + t[1]) + (t[2] + t[3]); }
            rsv[tid] = rsqrtf(s * (1.0f / 3072.0f) + EPS); }
        if (!gfix) SP_STAGEW(g);
#pragma unroll
        for (int v = 0; v < 12; ++v) { const int idx = tid + 512 * v, r = idx / 48, ch = idx % 48, t = ch >> 2, a = ch & 3;
            *(LAS u32x2*)(Vt + r * 800 + (32 * t + 4 * a) * 2) = (u32x2){vreg[v].x, vreg[v].y}; *(LAS u32x2*)(Vt + r * 800 + (32 * t + 16 + 4 * a) * 2) = (u32x2){vreg[v].z, vreg[v].w}; }
        if (u + C.G < 1024) SP_LOADV(u + C.G);
        const int i = 16 * w + fr; const size_t row = (size_t)128 * c + i;
        __syncthreads();
        const float bias = bsp[g * 128 + i];
#pragma unroll 1
        for (int hf = 0; hf < 2; ++hf) {
            u32x4 uu[6];
#pragma unroll
            for (int t = 0; t < 6; ++t) uu[t] = *(const u32x4*)(UV + row * AFF + 384 * g + 192 * hf + 32 * t + 8 * fq);
            f32x4 acc[12];
#pragma unroll
            for (int nb = 0; nb < 12; ++nb) acc[nb] = (f32x4){0.f, 0.f, 0.f, 0.f};
            LAS const char* vlb = Vt + (8 * fq) * 800 + TR_LANE_OFF(C.lane, 800);
#pragma unroll
            for (int kk = 0; kk < 4; ++kk) if (32 * kk <= 16 * w + 15) {
                const u32x4 bwr = *(const LAS u32x4*)(Wt + (16 * w + fr) * 272 + (32 * kk + 8 * fq) * 2);
                const f32x4 r0 = *(const LAS f32x4*)(rsv + 32 * kk + 8 * fq), r1 = *(const LAS f32x4*)(rsv + 32 * kk + 8 * fq + 4);
                const bf16x8 bw = __builtin_bit_cast(bf16x8, pk8(unpk4((u32x2){bwr.x, bwr.y}) * r0, unpk4((u32x2){bwr.z, bwr.w}) * r1));
#pragma unroll
                for (int nb = 0; nb < 12; ++nb) { const bf16x8 av = tr_frag_b(vlb + (32 * kk) * 800 + 384 * hf, 4 * 800, 16 * nb); acc[nb] = MFMA16(av, bw, acc[nb]); } }
#pragma unroll
            for (int t = 0; t < 6; ++t) { const int col = 384 * g + 192 * hf + 32 * t + 8 * fq; const f32x4 n0 = *(const f32x4*)(nv + col), n1 = *(const f32x4*)(nv + col + 4);
                const f32x4 u0 = unpk4((u32x2){uu[t].x, uu[t].y}), u1 = unpk4((u32x2){uu[t].z, uu[t].w});
                *(u32x4*)(GT + row * AH + col) = pk8(u0 * (acc[2 * t] * n0 + bias), u1 * (acc[2 * t + 1] * n1 + bias)); }
        }
        __syncthreads();
    }
#undef SP_LOADV
#undef SP_STAGEW
    float* ocv = C.out + O_CV + (size_t)L * 128 * 4 * AH;
    for (int su = C.bid; su < 256; su += C.G) { const int s = su >> 1, chalf = su & 1;
        if (tid < 4) { const f32x4* p = (const f32x4*)(VSS + (size_t)(MP + 4 * s + tid) * 48); float sm = 0.f;
#pragma unroll
            for (int k = 0; k < 12; ++k) { const f32x4 t = p[k]; sm += (t[0] + t[1]) + (t[2] + t[3]); }
            rsv[tid] = rsqrtf(sm * (1.0f / 3072.0f) + EPS); }
        __syncthreads();
        for (int cg = 384 * chalf + tid; cg < 384 * chalf + 384; cg += 512) { const int col = 4 * cg, g = col / 384; const f32x4 nvv = *(const f32x4*)(nv + col);
            f32x4 vn[4];
#pragma unroll
            for (int t = 0; t < 4; ++t) { const size_t row = (size_t)MP + 4 * s + t; vn[t] = unpk4(*(const u32x2*)(UV + row * AFF + AH + col)) * rsv[t] * nvv;
                nts(vn[t], (f32x4*)(ocv + ((size_t)s * 4 + t) * AH + col)); }
#pragma unroll
            for (int i = 0; i < 4; ++i) { const size_t row = (size_t)MP + 4 * s + i; f32x4 sv = (f32x4){0.f, 0.f, 0.f, 0.f};
#pragma unroll
                for (int j = 0; j <= i; ++j) sv += vn[j] * wsp[(size_t)(g * 128 + i) * 128 + j];
                sv += bsp[g * 128 + i];
                *(u32x2*)(GT + row * AH + col) = pk4(unpk4(*(const u32x2*)(UV + row * AFF + col)) * sv); } }
        __syncthreads();
    }
}

__device__ __forceinline__ int t5_bucket(int rel) {
    if (rel < 16) return rel;
    int lg = 16 + (int)(__logf((float)rel / 16.0f) / 2.0794415416798357f * 16.0f); return lg < 31 ? lg : 31;
}
__device__ __forceinline__ void phase_attn(const Ctx& C0) {
    const Ctx C = ctx_local(C0);
    const bf16_t* QKV = WSP(bf16_t, WS_QKV); bf16_t* O = WSP(bf16_t, WS_O);
    const float* relb = GIN(I_RELB); const float* sinks = GIN(I_BSINK);
    const int w = C.wave, fr = C.fr, fq = C.fq, tid = C.tid, lane = C.lane;
    {
        LAS char* Kt = C.lds; LAS char* Vt = C.lds + 36864; LAS float* bt = (LAS float*)(C.lds + 73728);
        u32x4 kreg[4], vreg[4];
#define ATT_LOADKV(uu) do { const int qb_ = (uu) & 31, kh_ = ((uu) >> 5) & 3, b_ = (uu) >> 7; _Pragma("unroll") for (int v = 0; v < 4; ++v) { const int idx = tid + 512 * v, r = idx >> 3, ch = idx & 7; const int pos = 128 * (qb_ - 1) + r; \
            kreg[v] = (u32x4){0u, 0u, 0u, 0u}; vreg[v] = kreg[v]; \
            if (pos >= 0) { const size_t row = (size_t)b_ * 4096 + pos; kreg[v] = *(const u32x4*)(QKV + row * NQKV + 1024 + 64 * kh_ + 8 * ch); vreg[v] = *(const u32x4*)(QKV + row * NQKV + 1280 + 64 * kh_ + 8 * ch); } } } while (0)
#ifdef ATT_REP_PROMPT
        for (int rep_ = 0; rep_ < 2; ++rep_) {
#endif
        if (C.bid < 512) ATT_LOADKV(C.bid);
        for (int u = C.bid; u < 512; u += C.G) {
            const int qb = u & 31, kh = (u >> 5) & 3, b = u >> 7;
#pragma unroll
            for (int v = 0; v < 4; ++v) { const int idx = tid + 512 * v, r = idx >> 3, ch = idx & 7;
                *(LAS u32x4*)(Kt + r * 144 + ch * 16) = kreg[v]; *(LAS u32x4*)(Vt + r * 144 + ch * 16) = vreg[v]; }
            if (tid < 128) { const int bk = t5_bucket(tid);
#pragma unroll
                for (int r = 0; r < 4; ++r) bt[tid * 4 + r] = relb[bk * 16 + 4 * kh + r]; }
            __syncthreads();
            if (qb == 31) {
                float* okp = C.out + O_KP; float* ovp = C.out + O_VP;
                for (int idx = tid; idx < 1024; idx += 512) { const int r = idx >> 3, ch = idx & 7;
                    const u32x4 kv = *(const LAS u32x4*)(Kt + (128 + r) * 144 + ch * 16), vv = *(const LAS u32x4*)(Vt + (128 + r) * 144 + ch * 16);
                    const size_t o = (((size_t)b * 128 + r) * 4 + kh) * 64 + 8 * ch;
                    *(f32x4*)(okp + o) = unpk4((u32x2){kv.x, kv.y}); *(f32x4*)(okp + o + 4) = unpk4((u32x2){kv.z, kv.w});
                    *(f32x4*)(ovp + o) = unpk4((u32x2){vv.x, vv.y}); *(f32x4*)(ovp + o + 4) = unpk4((u32x2){vv.z, vv.w}); }
            }
            const int rh = w >> 1, head = 4 * kh + rh; const float sink = sinks[head];
            if (u + C.G < 512) ATT_LOADKV(u + C.G);
            bf16x8 qn[2];
#pragma unroll
            for (int kk = 0; kk < 2; ++kk) qn[kk] = *(const bf16x8*)(QKV + ((size_t)b * 4096 + 128 * qb + (w & 1) * 64 + fr) * NQKV + 64 * head + 32 * kk + 8 * fq);
#pragma unroll 1
            for (int it = 0; it < 4; ++it) {
                const int qi0 = ((w & 1) * 4 + it) * 16, qi = qi0 + fr; const size_t qrow = (size_t)b * 4096 + 128 * qb + qi;
                bf16x8 qf[2];
#pragma unroll
                for (int kk = 0; kk < 2; ++kk) { qf[kk] = qn[kk]; if (it < 3) qn[kk] = *(const bf16x8*)(QKV + (qrow + 16) * NQKV + 64 * head + 32 * kk + 8 * fq); }
                const int nbs = (qi0 >> 4) & ~1;
                f32x4 sa[10];
#pragma unroll
                for (int jb = 0; jb < 10; ++jb) { sa[jb] = (f32x4){0.f, 0.f, 0.f, 0.f};
#pragma unroll
                    for (int kk = 0; kk < 2; ++kk) { const bf16x8 kf = *(const LAS bf16x8*)(Kt + (16 * (nbs + jb) + fr) * 144 + (32 * kk + 8 * fq) * 2); sa[jb] = MFMA16(kf, qf[kk], sa[jb]); } }
                float mx = sink;
#pragma unroll
                for (int jb = 0; jb < 10; ++jb)
#pragma unroll
                    for (int e = 0; e < 4; ++e) { const int kj = 16 * (nbs + jb) + 4 * fq + e, rel = 128 + qi - kj; const bool valid = (rel >= 0) && (rel < 128) && (qb > 0 || kj >= 128);
                        const int rc = rel < 0 ? 0 : (rel > 127 ? 127 : rel);
                        const float l = valid ? sa[jb][e] * 0.125f + bt[rc * 4 + rh] : -1e30f; sa[jb][e] = l; mx = fmaxf(mx, l); }
                mx = fmaxf(mx, __shfl_xor(mx, 16)); mx = fmaxf(mx, __shfl_xor(mx, 32));
                float sum = 0.f;
#pragma unroll
                for (int jb = 0; jb < 10; ++jb)
#pragma unroll
                    for (int e = 0; e < 4; ++e) { const float p = __expf(sa[jb][e] - mx); sa[jb][e] = p; sum += p; }
                sum += __shfl_xor(sum, 16); sum += __shfl_xor(sum, 32);
                const float inv = 1.0f / (sum + __expf(sink - mx));
                f32x4 oa[4];
#pragma unroll
                for (int db = 0; db < 4; ++db) oa[db] = (f32x4){0.f, 0.f, 0.f, 0.f};
                LAS const char* vlb = Vt + (4 * fq) * 144 + TR_LANE_OFF(lane, 144);
#pragma unroll
                for (int s5 = 0; s5 < 5; ++s5) { const u32x4 pw = pk8(sa[2 * s5], sa[2 * s5 + 1]); const bf16x8 pf = __builtin_bit_cast(bf16x8, pw); const int k0 = 16 * nbs + 32 * s5;
#pragma unroll
                    for (int db = 0; db < 4; ++db) { const bf16x8 vf = tr_frag_b(vlb + (16 * nbs + 32 * s5) * 144, 16 * 144, 16 * db); oa[db] = MFMA16(vf, pf, oa[db]); } }
#pragma unroll
                for (int db = 0; db < 4; ++db) *(u32x2*)(O + qrow * DM + 64 * head + 16 * db + 4 * fq) = pk4(oa[db] * inv);
            }
            __syncthreads();
        }
#ifdef ATT_REP_PROMPT
        }
#endif
    }
#undef ATT_LOADKV
    {
        LAS float* btS = (LAS float*)C.lds;
        LAS char* Vw = C.lds + 8192 + w * 24576;
        const float* ck = GIN(I_CK); const float* cv = GIN(I_CV); float* oks = C.out + O_KS; float* ovs = C.out + O_VS;
        for (int e = tid; e < 2048; e += 512) btS[e] = relb[t5_bucket(e >> 4) * 16 + (e & 15)];
        __syncthreads();
        for (int u = w * C.G + C.bid; u < 512 && w < 6; u += 6 * C.G) {
            const int s = u >> 2, kh = u & 3; const size_t cbase = ((size_t)s * 128 * 4 + kh) * 64;
            const bf16_t* nrow = QKV + ((size_t)MP + 4 * s) * NQKV;
#pragma unroll 4
            for (int it = 0; it < 20; ++it) { const int e = lane + 64 * it, idx = e >> 3, ch = e & 7; u32x4 v = (u32x4){0u, 0u, 0u, 0u};
                if (idx < 128) { const float* p = cv + cbase + (size_t)idx * 256 + 8 * ch; v = pk8(ntl((const f32x4*)p), ntl((const f32x4*)(p + 4))); }
                else if (idx < 132) v = *(const u32x4*)(nrow + (size_t)(idx - 128) * NQKV + 1280 + 64 * kh + 8 * ch);
                *(LAS u32x4*)(Vw + idx * 144 + ch * 16) = v; }
#pragma unroll 4
            for (int it = 0; it < 32; ++it) { const int e = lane + 64 * it, j = e >> 4, c4 = (e & 15) * 4; const size_t o = cbase + (size_t)j * 256 + c4; f32x4 kv, vv;
                if (j < 124) { kv = ntl((const f32x4*)(ck + o + 4 * 256)); vv = ntl((const f32x4*)(cv + o + 4 * 256)); }
                else { kv = unpk4(*(const u32x2*)(nrow + (size_t)(j - 124) * NQKV + 1024 + 64 * kh + c4)); vv = unpk4(*(const u32x2*)(nrow + (size_t)(j - 124) * NQKV + 1280 + 64 * kh + c4)); }
                nts(kv, (f32x4*)(oks + o)); nts(vv, (f32x4*)(ovs + o)); }
            const int r = fr >> 2, t = fr & 3, head = 4 * kh + r; const size_t qrow = (size_t)MP + 4 * s + t;
            bf16x8 qf[2];
#pragma unroll
            for (int kk = 0; kk < 2; ++kk) qf[kk] = *(const bf16x8*)(QKV + qrow * NQKV + 64 * head + 32 * kk + 8 * fq);
            f32x4 sa[9];
#pragma unroll
            for (int nb = 0; nb < 9; ++nb) { sa[nb] = (f32x4){0.f, 0.f, 0.f, 0.f}; const int idx = 16 * nb + fr;
#pragma unroll
                for (int kk = 0; kk < 2; ++kk) { u32x4 kv = (u32x4){0u, 0u, 0u, 0u};
                    if (nb < 8) { const float* p = ck + cbase + (size_t)idx * 256 + 32 * kk + 8 * fq; kv = pk8(ntl((const f32x4*)p), ntl((const f32x4*)(p + 4))); }
                    else if (fr < 4) kv = *(const u32x4*)(nrow + (size_t)fr * NQKV + 1024 + 64 * kh + 32 * kk + 8 * fq);
                    sa[nb] = MFMA16(__builtin_bit_cast(bf16x8, kv), qf[kk], sa[nb]); } }
            const float sink = sinks[head]; float mx = sink;
#pragma unroll
            for (int nb = 0; nb < 9; ++nb)
#pragma unroll
                for (int e = 0; e < 4; ++e) { const int idx = 16 * nb + 4 * fq + e, rel = t + 128 - idx; const bool valid = (rel >= 0) && (rel < 128);
                    const float l = valid ? sa[nb][e] * 0.125f + btS[(valid ? rel : 0) * 16 + head] : -1e30f; sa[nb][e] = l; mx = fmaxf(mx, l); }
            mx = fmaxf(mx, __shfl_xor(mx, 16)); mx = fmaxf(mx, __shfl_xor(mx, 32));
            float sum = 0.f;
#pragma unroll
            for (int nb = 0; nb < 9; ++nb)
#pragma unroll
                for (int e = 0; e < 4; ++e) { const float p = __expf(sa[nb][e] - mx); sa[nb][e] = p; sum += p; }
            sum += __shfl_xor(sum, 16); sum += __shfl_xor(sum, 32);
            const float inv = 1.0f / (sum + __expf(sink - mx));
            f32x4 oa[4];
#pragma unroll
            for (int db = 0; db < 4; ++db) oa[db] = (f32x4){0.f, 0.f, 0.f, 0.f};
            LAS const char* vlb = Vw + (4 * fq) * 144 + TR_LANE_OFF(lane, 144);
#pragma unroll
            for (int s5 = 0; s5 < 5; ++s5) { const u32x4 pw = pk8(sa[2 * s5], s5 < 4 ? sa[2 * s5 + 1] : (f32x4){0.f, 0.f, 0.f, 0.f}); const bf16x8 pf = __builtin_bit_cast(bf16x8, pw);
#pragma unroll
                for (int db = 0; db < 4; ++db) { const bf16x8 vf = tr_frag_b(vlb + (32 * s5) * 144, 16 * 144, 16 * db); oa[db] = MFMA16(vf, pf, oa[db]); } }
#pragma unroll
            for (int db = 0; db < 4; ++db) *(u32x2*)(O + qrow * DM + 64 * head + 16 * db + 4 * fq) = pk4(oa[db] * inv);
        }
        __syncthreads();
    }
}
template <int NCH> __device__ __forceinline__ void stage_conv(const bf16_t* XR, const float* cw, const float* cb, size_t row0, int pos0, int col0, LAS char* dst, int pitch, int tstride, const LAS float* sc, int tid) {
    constexpr int RG = NCH * 128 / 512;
    const int ch = tid % NCH, r0 = (tid / NCH) * RG, col = col0 + 8 * ch;
    f32x4 w0[4], w1[4];
#pragma unroll
    for (int tap = 0; tap < 4; ++tap) { w0[tap] = *(const f32x4*)(cw + tap * CXBC + col); w1[tap] = *(const f32x4*)(cw + tap * CXBC + col + 4); }
    const f32x4 b0 = *(const f32x4*)(cb + col), b1 = *(const f32x4*)(cb + col + 4);
    u32x4 raw[RG + 3];
#pragma unroll
    for (int k = 0; k < RG + 3; ++k) { raw[k] = (u32x4){0u, 0u, 0u, 0u}; if (pos0 + r0 - 3 + k >= 0) raw[k] = *(const u32x4*)(XR + (row0 + r0 - 3 + k) * CXBC + col); }
    LAS char* d = dst + (ch >> 3) * tstride + (ch & 7) * 16;
#pragma unroll
    for (int q = 0; q < RG; ++q) { f32x4 a0 = b0, a1 = b1;
#pragma unroll
        for (int tap = 0; tap < 4; ++tap) { const u32x4 x = raw[q + tap]; a0 += unpk4((u32x2){x.x, x.y}) * w0[tap]; a1 += unpk4((u32x2){x.z, x.w}) * w1[tap]; }
#pragma unroll
        for (int e = 0; e < 4; ++e) { a0[e] = silu_f(a0[e]); a1[e] = silu_f(a1[e]); }
        if (sc) { const float s = sc[(ch >> 3) * 128 + r0 + q]; a0 = a0 * s; a1 = a1 * s; }
        *(LAS u32x4*)(d + (r0 + q) * pitch) = pk8(a0, a1); }
}
__device__ __forceinline__ void conv_small(const Ctx& C) {
    const bf16_t* XR = WSP(bf16_t, WS_XBCR); bf16_t* XCS = WSP(bf16_t, WS_XBCC);
    const float* cw = GIN(I_CCW); const float* cb = GIN(I_CCB); const float* sc = GIN(I_CONV);
    float* ocp = C.out + O_CONVP; float* ocs = C.out + O_CONVS;
    for (int it = C.bid * 512 + C.tid; it < MS * 384; it += C.G * 512) {
        const int srow = it / 384, col = (it % 384) * 8;
        f32x4 a0 = *(const f32x4*)(cb + col), a1 = *(const f32x4*)(cb + col + 4);
        const int s = srow >> 2, t = srow & 3;
#pragma unroll
        for (int tap = 0; tap < 4; ++tap) { const int xi = t + tap; f32x4 x0, x1;
            if (xi < 3) { const float* p = sc + ((size_t)s * 3 + xi) * CXBC + col; x0 = *(const f32x4*)p; x1 = *(const f32x4*)(p + 4); }
            else { const u32x4 x = *(const u32x4*)(XR + (size_t)(MP + 4 * s + xi - 3) * CXBC + col); x0 = unpk4((u32x2){x.x, x.y}); x1 = unpk4((u32x2){x.z, x.w}); }
            a0 += x0 * *(const f32x4*)(cw + tap * CXBC + col); a1 += x1 * *(const f32x4*)(cw + tap * CXBC + col + 4);
            if (tap == 3 && t >= 1) { float* o = ocs + ((size_t)s * 3 + (t - 1)) * CXBC + col; *(f32x4*)o = x0; *(f32x4*)(o + 4) = x1; } }
#pragma unroll
        for (int e = 0; e < 4; ++e) { a0[e] = silu_f(a0[e]); a1[e] = silu_f(a1[e]); }
        *(u32x4*)(XCS + (size_t)srow * CXBC + col) = pk8(a0, a1);
    }
    for (int it = C.bid * 512 + C.tid; it < 4 * 3 * 384; it += C.G * 512) { const int col = (it % 384) * 8, k = (it / 384) % 3, b = it / (3 * 384);
        const u32x4 x = *(const u32x4*)(XR + ((size_t)b * 4096 + 4093 + k) * CXBC + col); float* o = ocp + ((size_t)b * 3 + k) * CXBC + col;
        *(f32x4*)o = unpk4((u32x2){x.x, x.y}); *(f32x4*)(o + 4) = unpk4((u32x2){x.z, x.w}); }
}

__device__ __forceinline__ void phase_states(const Ctx& C0) {
    const Ctx C = ctx_local(C0);
    const bf16_t* XR = WSP(bf16_t, WS_XBCR); const float* cw = GIN(I_CCW); const float* cb = GIN(I_CCB); const float* DT = WSP(float, WS_DT); float* ACS = WSP(float, WS_ACS); float* CDEC = WSP(float, WS_CDEC);
    bf16_t* ST = WSP(bf16_t, WS_STATES); bf16_t* YI = WSP(bf16_t, WS_YG); bf16_t* CSV = WSP(bf16_t, WS_CSAVE); const float* Dsk = GIN(I_CD);
    conv_small(C);
    LAS char* Bt = C.lds; LAS char* cbL = C.lds + 34816; LAS char* XB = C.lds + 69632;
    LAS float* acsL = (LAS float*)(C.lds + 143360); LAS float* dtL = (LAS float*)(C.lds + 147456); LAS float* scL = (LAS float*)(C.lds + 151552);
    const int w = C.wave, fr = C.fr, fq = C.fq, tid = C.tid, lane = C.lane;
    for (int u = C.bid; u < 512; u += C.G) {
        const int g = u & 3, c = (u >> 2) & 31, b = u >> 7; const size_t row0 = (size_t)b * 4096 + 128 * c;
        {
            const int h = 8 * g + w; const float A = -__expf(GIN(I_CALOG)[h]);
            const int t0 = 2 * lane; const float d0 = DT[(row0 + t0) * 32 + h], d1 = DT[(row0 + t0 + 1) * 32 + h];
            const float a0 = d0 * A, a1 = d1 * A; float s = a0 + a1;
#pragma unroll
            for (int off = 1; off < 64; off <<= 1) { const float v = __shfl_up(s, off); if (lane >= off) s += v; }
            const float acs1 = s, acs0 = s - a1; const float tot = __shfl(s, 63);
            ACS[(row0 + t0) * 32 + h] = acs0; ACS[(row0 + t0 + 1) * 32 + h] = acs1;
            acsL[w * 128 + t0] = acs0; acsL[w * 128 + t0 + 1] = acs1; dtL[w * 128 + t0] = d0; dtL[w * 128 + t0 + 1] = d1;
            scL[w * 128 + t0] = __expf(tot - acs0) * d0; scL[w * 128 + t0 + 1] = __expf(tot - acs1) * d1;
            if (lane == 63) CDEC[((size_t)b * 32 + c) * 32 + h] = __expf(tot);
        }
        stage_conv<16>(XR, cw, cb, row0, 128 * c, 2048 + 128 * g, Bt, 272, 128, nullptr, tid);
        stage_conv<16>(XR, cw, cb, row0, 128 * c, 2560 + 128 * g, XB, 272, 128, nullptr, tid);
        __syncthreads();
        {
            bf16_t* cs = CSV + (((size_t)b * 32 + c) * 4 + g) * 16384;
#pragma unroll
            for (int v = 0; v < 4; ++v) { const int idx = tid + 512 * v, r = idx >> 4, ch = idx & 15; *(u32x4*)(cs + r * 128 + 8 * ch) = *(const LAS u32x4*)(XB + r * 272 + ch * 16); } }
#pragma unroll
        for (int jb = 0; jb < 8; ++jb) { f32x4 a = (f32x4){0.f, 0.f, 0.f, 0.f};
            if (jb <= w) {
#pragma unroll
                for (int kk = 0; kk < 4; ++kk) { const bf16x8 af = *(const LAS bf16x8*)(Bt + (16 * jb + fr) * 272 + (32 * kk + 8 * fq) * 2);
                    const bf16x8 bf = *(const LAS bf16x8*)(XB + (16 * w + fr) * 272 + (32 * kk + 8 * fq) * 2); a = MFMA16(af, bf, a); } }
            *(LAS u32x2*)(cbL + (16 * w + fr) * 272 + (16 * jb + 4 * fq) * 2) = pk4(a); }
        __syncthreads();
        for (int rd = 0; rd < 2; ++rd) {
            stage_conv<32>(XR, cw, cb, row0, 128 * c, 64 * (8 * g + 4 * rd), XB, 144, 18432, nullptr, tid);
            __syncthreads();
            const int hl = w >> 1, half = w & 1, hidx = 4 * rd + hl, head = 8 * g + hidx; LAS const char* Xh = XB + hl * 18432;
            {
                f32x4 acc[4][4];
#pragma unroll
                for (int nb = 0; nb < 4; ++nb)
#pragma unroll
                    for (int pb = 0; pb < 4; ++pb) acc[nb][pb] = (f32x4){0.f, 0.f, 0.f, 0.f};
#pragma unroll
                for (int kk = 0; kk < 4; ++kk) { bf16x8 xf[4];
                    const f32x4 s0 = *(const LAS f32x4*)(scL + hidx * 128 + 32 * kk + 8 * fq), s1 = *(const LAS f32x4*)(scL + hidx * 128 + 32 * kk + 8 * fq + 4);
#pragma unroll
                    for (int pb = 0; pb < 4; ++pb) { const u32x4 xr = __builtin_bit_cast(u32x4, tr_frag_b(Xh + (32 * kk + 8 * fq) * 144 + TR_LANE_OFF(lane, 144), 4 * 144, 16 * pb));
                        xf[pb] = __builtin_bit_cast(bf16x8, pk8(unpk4((u32x2){xr.x, xr.y}) * s0, unpk4((u32x2){xr.z, xr.w}) * s1)); }
#pragma unroll
                    for (int nb = 0; nb < 4; ++nb) { const bf16x8 af = tr_frag_b(Bt + (32 * kk + 8 * fq) * 272 + TR_LANE_OFF(lane, 272) + 128 * half, 4 * 272, 16 * nb);
#pragma unroll
                        for (int pb = 0; pb < 4; ++pb) acc[nb][pb] = MFMA16(af, xf[pb], acc[nb][pb]); } }
                bf16_t* su = ST + (((size_t)b * 32 + c) * 32 + head) * 8192;
#pragma unroll
                for (int nb = 0; nb < 4; ++nb)
#pragma unroll
                    for (int pb = 0; pb < 4; ++pb) { const int nbp = 4 * half + nb;
                        *(u32x2*)(su + ((((pb * 4 + (nbp >> 1)) * 4 + 2 * (nbp & 1) + (fq >> 1)) * 16 + fr) * 8 + 4 * (fq & 1))) = pk4(acc[nb][pb]); }
            }
            {
                const float dsk = Dsk[head];
#pragma unroll 1
                for (int ibl = 0; ibl < 4; ++ibl) {
                    const int ib = 4 * half + ibl, i = 16 * ib + fr; const float ai = acsL[hidx * 128 + i];
                    f32x4 a1[4];
#pragma unroll
                    for (int pb = 0; pb < 4; ++pb) a1[pb] = (f32x4){0.f, 0.f, 0.f, 0.f};
                    const int nk = ((16 * ib + 15) >> 5) + 1;
                    for (int kk = 0; kk < nk; ++kk) { const int j0 = 32 * kk + 8 * fq;
                        const u32x4 cbv = *(const LAS u32x4*)(cbL + i * 272 + j0 * 2);
                        const f32x4 c0 = unpk4((u32x2){cbv.x, cbv.y}), c1 = unpk4((u32x2){cbv.z, cbv.w});
                        const f32x4 aj0 = *(const LAS f32x4*)(acsL + hidx * 128 + j0), aj1 = *(const LAS f32x4*)(acsL + hidx * 128 + j0 + 4);
                        const f32x4 dj0 = *(const LAS f32x4*)(dtL + hidx * 128 + j0), dj1 = *(const LAS f32x4*)(dtL + hidx * 128 + j0 + 4);
                        f32x4 w0, w1;
#pragma unroll
                        for (int e = 0; e < 4; ++e) { w0[e] = (j0 + e <= i) ? c0[e] * __expf(ai - aj0[e]) * dj0[e] : 0.f; w1[e] = (j0 + 4 + e <= i) ? c1[e] * __expf(ai - aj1[e]) * dj1[e] : 0.f; }
                        const bf16x8 wf = __builtin_bit_cast(bf16x8, pk8(w0, w1));
#pragma unroll
                        for (int pb = 0; pb < 4; ++pb) { const bf16x8 xf = tr_frag_b(Xh + j0 * 144 + TR_LANE_OFF(lane, 144), 4 * 144, 16 * pb); a1[pb] = MFMA16(xf, wf, a1[pb]); } }
#pragma unroll
                    for (int pb = 0; pb < 4; ++pb) { const f32x4 xv = unpk4(*(const LAS u32x2*)(Xh + i * 144 + (16 * pb + 4 * fq) * 2));
                        *(u32x2*)(YI + (row0 + i) * CDI + 64 * head + 16 * pb + 4 * fq) = pk4(a1[pb] + xv * dsk); }
                }
            }
            __syncthreads();
        }
    }
}

__device__ __forceinline__ void phase_scan(const Ctx& C0) {
    const Ctx C = ctx_local(C0);
    const bf16_t* ST = WSP(bf16_t, WS_STATES); bf16_t* HP = WSP(bf16_t, WS_HPREV); const float* CDEC = WSP(float, WS_CDEC); float* osp = C.out + O_SSMP;
    for (int idx = C.bid * 512 + C.tid; idx < 131072; idx += C.G * 512) {
        const int cq = idx & 1023, bh = idx >> 10, b = bh >> 5, h = bh & 31;
        const int p = 16 * (cq >> 8) + (cq & 15), n0 = 32 * ((cq >> 6) & 3) + 8 * ((cq >> 4) & 3);
        f32x4 h0 = (f32x4){0.f, 0.f, 0.f, 0.f}, h1 = h0;
#pragma unroll 1
        for (int c8 = 0; c8 < 32; c8 += 8) { u32x4 st[8]; float dec[8];
#pragma unroll
            for (int q = 0; q < 8; ++q) { const size_t un = ((size_t)b * 32 + c8 + q) * 32 + h; st[q] = *(const u32x4*)(ST + un * 8192 + cq * 8); dec[q] = CDEC[un]; }
#pragma unroll
            for (int q = 0; q < 8; ++q) { const size_t un = ((size_t)b * 32 + c8 + q) * 32 + h;
                *(u32x4*)(HP + un * 8192 + cq * 8) = pk8(h0, h1);
                h0 = h0 * dec[q] + unpk4((u32x2){st[q].x, st[q].y}); h1 = h1 * dec[q] + unpk4((u32x2){st[q].z, st[q].w}); } }
        float* o = osp + ((size_t)bh * 64 + p) * 128 + n0; nts(h0, (f32x4*)o); nts(h1, (f32x4*)(o + 4));
    }
}

__device__ __forceinline__ void phase_ssdy(const Ctx& C0) {
    const Ctx C = ctx_local(C0);
    const bf16_t* XC = WSP(bf16_t, WS_XBCC) - (size_t)MP * CXBC;
    const bf16_t* Z = WSP(bf16_t, WS_Z); const float* DT = WSP(float, WS_DT); const float* ACS = WSP(float, WS_ACS);
    const bf16_t* HP = WSP(bf16_t, WS_HPREV); bf16_t* YG = WSP(bf16_t, WS_YG); float* GRS = WSP(float, WS_GRS); const bf16_t* CSV = WSP(bf16_t, WS_CSAVE);
    const float* Dsk = GIN(I_CD); const float* nw = GIN(I_CNORM);
    const int w = C.wave, fr = C.fr, fq = C.fq, tid = C.tid, lane = C.lane;
    {
        LAS char* Ct = C.lds; LAS float* acsL = (LAS float*)(C.lds + 34816); LAS float* gss = (LAS float*)(C.lds + 34816 + 4096);
        for (int u = C.bid; u < 512; u += C.G) {
            const int g = u & 3, c = (u >> 2) & 31, b = u >> 7; const size_t row0 = (size_t)b * 4096 + 128 * c; const int head = 8 * g + w;
            const bf16_t* hp = HP + (((size_t)b * 32 + c) * 32 + head) * 8192;
            bf16x8 hpf[4][4];
#pragma unroll
            for (int kk = 0; kk < 4; ++kk)
#pragma unroll
                for (int pb = 0; pb < 4; ++pb) hpf[kk][pb] = *(const bf16x8*)(hp + (((pb * 4 + kk) * 4 + fq) * 16 + fr) * 8);
            { const bf16_t* cs = CSV + (((size_t)b * 32 + c) * 4 + g) * 16384;
#pragma unroll
              for (int v = 0; v < 4; ++v) { const int idx = tid + 512 * v, r = idx >> 4, ch = idx & 15; *(LAS u32x4*)(Ct + r * 272 + ch * 16) = *(const u32x4*)(cs + r * 128 + 8 * ch); }
#pragma unroll
              for (int v = 0; v < 2; ++v) { const int e = tid + 512 * v, hh = e >> 7, t = e & 127; acsL[e] = ACS[(row0 + t) * 32 + 8 * g + hh]; } }
            __syncthreads();
            LAS float* tsc = (LAS float*)(C.lds + 49152) + w * 1088;
            const int er = lane >> 2, ec = (lane & 3) * 16;
            u32x4 yc[2], zc[2], yn[2], zn[2];
#pragma unroll
            for (int h2 = 0; h2 < 2; ++h2) { const size_t o = (row0 + er) * CDI + 64 * head + ec + 8 * h2; yc[h2] = *(const u32x4*)(YG + o); zc[h2] = *(const u32x4*)(Z + o); }
#pragma unroll 1
            for (int ib = 0; ib < 8; ++ib) { const int i = 16 * ib + fr;
                if (ib < 7) {
#pragma unroll
                    for (int h2 = 0; h2 < 2; ++h2) { const size_t o = (row0 + 16 * ib + 16 + er) * CDI + 64 * head + ec + 8 * h2; yn[h2] = *(const u32x4*)(YG + o); zn[h2] = *(const u32x4*)(Z + o); } }
                f32x4 a2[4];
#pragma unroll
                for (int pb = 0; pb < 4; ++pb) a2[pb] = (f32x4){0.f, 0.f, 0.f, 0.f};
#pragma unroll
                for (int kk = 0; kk < 4; ++kk) { const bf16x8 cf = *(const LAS bf16x8*)(Ct + i * 272 + (32 * kk + 8 * fq) * 2);
#pragma unroll
                    for (int pb = 0; pb < 4; ++pb) a2[pb] = MFMA16(hpf[kk][pb], cf, a2[pb]); }
                const float ea = __expf(acsL[w * 128 + i]);
#pragma unroll
                for (int pb = 0; pb < 4; ++pb) *(LAS f32x4*)(tsc + fr * 68 + 16 * pb + 4 * fq) = a2[pb] * ea;
                f32x4 t4[4];
#pragma unroll
                for (int q = 0; q < 4; ++q) t4[q] = *(const LAS f32x4*)(tsc + er * 68 + ec + 4 * q);
                float ss = 0.f; u32x4 o2[2];
#pragma unroll
                for (int h2 = 0; h2 < 2; ++h2) { const f32x4 z0 = unpk4((u32x2){zc[h2].x, zc[h2].y}), z1 = unpk4((u32x2){zc[h2].z, zc[h2].w});
                    f32x4 y0 = unpk4((u32x2){yc[h2].x, yc[h2].y}) + t4[2 * h2], y1 = unpk4((u32x2){yc[h2].z, yc[h2].w}) + t4[2 * h2 + 1];
#pragma unroll
                    for (int e = 0; e < 4; ++e) { y0[e] *= silu_f(z0[e]); y1[e] *= silu_f(z1[e]); }
                    ss += sq4(y0) + sq4(y1); o2[h2] = pk8(y0, y1); }
#pragma unroll
                for (int h2 = 0; h2 < 2; ++h2) *(u32x4*)(YG + (row0 + 16 * ib + er) * CDI + 64 * head + ec + 8 * h2) = o2[h2];
                ss += __shfl_xor(ss, 1); ss += __shfl_xor(ss, 2);
                if ((lane & 3) == 0) gss[w * 128 + 16 * ib + er] = ss;
#pragma unroll
                for (int h2 = 0; h2 < 2; ++h2) { yc[h2] = yn[h2]; zc[h2] = zn[h2]; }
            }
            __syncthreads();
            if (tid < 128) { float tot = 0.f;
#pragma unroll
                for (int hh = 0; hh < 8; ++hh) tot += gss[hh * 128 + tid];
                GRS[(row0 + tid) * 4 + g] = rsqrtf(tot * (1.0f / 512.0f) + EPS); }
            __syncthreads();
        }
    }
    {
        LAS float* xS = (LAS float*)C.lds; LAS float* BS = xS + 8 * 4 * 64; LAS float* CS = BS + 512; LAS float* yI = CS + 512; LAS float* gsS = yI + 8 * 4 * 64; LAS float* wL = gsS + 32;
        const float* h0p = GIN(I_SSM); float* oss = C.out + O_SSMS;
        for (int u = C.bid; u < 512; u += C.G) {
            const int s = u >> 2, g = u & 3, head = 8 * g + w; const size_t rowb = (size_t)MP + 4 * s;
            for (int e = tid; e < 512; e += 512) { const int t = e >> 7, n = e & 127; BS[e] = bf2f(XC[(rowb + t) * CXBC + 2048 + 128 * g + n]); CS[e] = bf2f(XC[(rowb + t) * CXBC + 2560 + 128 * g + n]); }
#pragma unroll
            for (int t = 0; t < 4; ++t) xS[(w * 4 + t) * 64 + lane] = bf2f(XC[(rowb + t) * CXBC + 64 * head + lane]);
            __syncthreads();
            const float A = -__expf(GIN(I_CALOG)[head]);
            float dt[4], acs[4];
#pragma unroll
            for (int t = 0; t < 4; ++t) { dt[t] = DT[(rowb + t) * 32 + head]; acs[t] = (t ? acs[t - 1] : 0.f) + dt[t] * A; }
            bf16x8 cfr[4], bfr[4];
#pragma unroll
            for (int kk = 0; kk < 4; ++kk) { u32x4 cv = (u32x4){0u, 0u, 0u, 0u}, bv = cv;
                if (fr < 4) { cv = *(const u32x4*)(XC + (rowb + fr) * CXBC + 2560 + 128 * g + 32 * kk + 8 * fq); bv = *(const u32x4*)(XC + (rowb + fr) * CXBC + 2048 + 128 * g + 32 * kk + 8 * fq); }
                cfr[kk] = __builtin_bit_cast(bf16x8, cv); bfr[kk] = __builtin_bit_cast(bf16x8, bv); }
            { f32x4 cbm = (f32x4){0.f, 0.f, 0.f, 0.f};
#pragma unroll
              for (int kk = 0; kk < 4; ++kk) cbm = MFMA16(bfr[kk], cfr[kk], cbm);
              if (lane < 4) { const float ai = lane == 0 ? acs[0] : lane == 1 ? acs[1] : lane == 2 ? acs[2] : acs[3];
#pragma unroll
                  for (int j = 0; j < 4; ++j) wL[(w * 4 + lane) * 4 + j] = (j <= lane) ? cbm[j] * __expf(ai - acs[j]) * dt[j] : 0.f; } }
            float yin[4];
#pragma unroll
            for (int i = 0; i < 4; ++i) { float y = 0.f;
#pragma unroll
                for (int j = 0; j <= i; ++j) y += wL[(w * 4 + i) * 4 + j] * xS[(w * 4 + j) * 64 + lane];
                yin[i] = y; }
            const float dec3 = __expf(acs[3]); float cj[4];
#pragma unroll
            for (int j = 0; j < 4; ++j) cj[j] = __expf(acs[3] - acs[j]) * dt[j];
            const size_t hb = ((size_t)s * 32 + head) * 8192;
#pragma unroll 1
            for (int pb = 0; pb < 4; ++pb) { const int p = 16 * pb + fr; f32x4 hlo[4], hhi[4];
#pragma unroll
                for (int kk = 0; kk < 4; ++kk) { const float* hp = h0p + hb + p * 128 + 32 * kk + 8 * fq; hlo[kk] = ntl((const f32x4*)hp); hhi[kk] = ntl((const f32x4*)(hp + 4)); }
                float xc[4];
#pragma unroll
                for (int j = 0; j < 4; ++j) xc[j] = xS[(w * 4 + j) * 64 + p] * cj[j];
                f32x4 ya = (f32x4){0.f, 0.f, 0.f, 0.f};
#pragma unroll
                for (int kk = 0; kk < 4; ++kk) { ya = MFMA16(__builtin_bit_cast(bf16x8, pk8(hlo[kk], hhi[kk])), cfr[kk], ya);
                    f32x4 lo = hlo[kk] * dec3, hi = hhi[kk] * dec3;
#pragma unroll
                    for (int j = 0; j < 4; ++j) { lo += *(const LAS f32x4*)(BS + j * 128 + 32 * kk + 8 * fq) * xc[j]; hi += *(const LAS f32x4*)(BS + j * 128 + 32 * kk + 8 * fq + 4) * xc[j]; }
                    float* op = oss + hb + p * 128 + 32 * kk + 8 * fq; nts(lo, (f32x4*)op); nts(hi, (f32x4*)(op + 4)); }
                if (fr < 4) { const float ea = __expf(fr == 0 ? acs[0] : fr == 1 ? acs[1] : fr == 2 ? acs[2] : acs[3]);
#pragma unroll
                    for (int r = 0; r < 4; ++r) yI[(w * 4 + fr) * 64 + 16 * pb + 4 * fq + r] = ya[r] * ea; } }
            __syncthreads();
            float gv[4]; const float dsk = Dsk[head];
#pragma unroll
            for (int i = 0; i < 4; ++i) { const float y = yin[i] + yI[(w * 4 + i) * 64 + lane] + dsk * xS[(w * 4 + i) * 64 + lane];
                gv[i] = y * silu_f(bf2f(Z[(rowb + i) * CDI + 64 * head + lane])); const float sq = wave_sum(gv[i] * gv[i]); if (lane == 0) gsS[w * 4 + i] = sq; }
            __syncthreads();
#pragma unroll
            for (int i = 0; i < 4; ++i) { float tot = 0.f;
#pragma unroll
                for (int hh = 0; hh < 8; ++hh) tot += gsS[hh * 4 + i];
                YG[(rowb + i) * CDI + 64 * head + lane] = (bf16_t)(pk2(gv[i], 0.f) & 0xffffu);
                if (w == 0 && lane == 0) GRS[(rowb + i) * 4 + g] = rsqrtf(tot * (1.0f / 512.0f) + EPS); }
            __syncthreads();
        }
    }
}
#define XB_TMO      128
#define XB_XCNT(j)  (256  + 64 * (j))
#define XB_XSUB(j)  (1280 + 64 * (j))
#define XB_XGEN(j)  (2304 + 64 * (j))
#define XB_TOP      3328
#define XB_TOPGEN   3392
#define XCD_BAR_WORDS 3456
#define XB_SPIN_CAP (1u << 18)
__device__ __forceinline__ unsigned xb_ld(unsigned* p)              { return __hip_atomic_load(p, __ATOMIC_RELAXED, __HIP_MEMORY_SCOPE_AGENT); }
__device__ __forceinline__ unsigned xb_add(unsigned* p, unsigned v) { return __hip_atomic_fetch_add(p, v, __ATOMIC_RELAXED, __HIP_MEMORY_SCOPE_AGENT); }
__device__ __forceinline__ unsigned xb_xcc_id() { return (unsigned)__builtin_amdgcn_s_getreg((3 << 11) | 20) & 0xFu; }
#define XB_SPIN(cond, bar) do { unsigned _sp = 0; while (cond) { __builtin_amdgcn_s_sleep(1); \
    if ((++_sp & 255u) == 0u) { if (xb_ld(&(bar)[XB_TMO])) break; if (_sp > XB_SPIN_CAP) { atomicAdd(&(bar)[XB_TMO], 1u); break; } } } } while (0)
__device__ __forceinline__ void xcd_barrier_complete(unsigned* bar, unsigned x, unsigned& nloc, unsigned& nx) {
    const unsigned G = gridDim.x * gridDim.y * gridDim.z;
    unsigned sum, cnt, mine, sp = 0u;
    for (;;) {
        sum = 0u; cnt = 0u; mine = 0u;
#pragma unroll
        for (unsigned j = 0; j < 16; ++j) { const unsigned c = xb_ld(&bar[XB_XCNT(j)]); sum += c; cnt += (c > 0u) ? 1u : 0u; mine = (j == x) ? c : mine; }
        if (sum == G) break;
        __builtin_amdgcn_s_sleep(1);
        if ((++sp & 255u) == 0u) { if (xb_ld(&bar[XB_TMO])) break; if (sp > XB_SPIN_CAP) { atomicAdd(&bar[XB_TMO], 1u); break; } }
    }
    nloc = mine > 0u ? mine : 1u; nx = cnt > 0u ? cnt : 1u;
}
__device__ __forceinline__ void xcd_barrier(unsigned* bar, volatile LAS unsigned* st) {
    asm volatile("s_waitcnt vmcnt(0)" ::: "memory");
    __syncthreads();
    if (threadIdx.x == 0) {
        const unsigned x = xb_xcc_id();
        __builtin_amdgcn_s_waitcnt(0);
        unsigned nloc = st[0], nx = st[1];
        if (nloc == 0u) { xcd_barrier_complete(bar, x, nloc, nx); st[0] = nloc; st[1] = nx; }
        const unsigned old = xb_add(&bar[XB_XSUB(x)], 1u);
        const unsigned gen = old / nloc;
        if (old + 1u == (gen + 1u) * nloc) {
            __builtin_amdgcn_fence(__ATOMIC_RELEASE, "agent");
            asm volatile("s_waitcnt vmcnt(0)" ::: "memory");
            const unsigned og = xb_add(&bar[XB_TOP], 1u);
            const unsigned tg = og / nx;
            if (og + 1u == (tg + 1u) * nx) xb_add(&bar[XB_TOPGEN], 1u);
            else XB_SPIN(xb_ld(&bar[XB_TOPGEN]) == tg, bar);
            __builtin_amdgcn_fence(__ATOMIC_ACQUIRE, "agent");
            xb_add(&bar[XB_XGEN(x)], 1u);
            asm volatile("s_waitcnt vmcnt(0)" ::: "memory");
        } else {
            XB_SPIN(xb_ld(&bar[XB_XGEN(x)]) == gen, bar);
            __builtin_amdgcn_fence(__ATOMIC_ACQUIRE, "agent");
            asm volatile("s_waitcnt vmcnt(0)" ::: "memory");
        }
    }
    __syncthreads();
}

constexpr int N_PHASES = 33;
constexpr int LDS_BYTES = 163840;
constexpr int LDS_BARST = 163840 - 16;
constexpr size_t CTL_BYTES = 65536;
constexpr int CW_BAR = 4096;
__host__ __device__ __forceinline__ bool phase_empty(int ph) { if (ph == 0) return false; const int L = (ph - 1) >> 3, loc = (ph - 1) & 7; return ((loc >= 2 && loc <= 4) && (L % 3 != 2)) || (loc == 1 && L % 3 == 2); }

__global__ void __launch_bounds__(512, 2) fwd(Args a) {
    extern __shared__ __attribute__((aligned(16))) unsigned char lds_raw[];
    if (threadIdx.x < 4) ((LAS unsigned*)((LAS char*)lds_raw + LDS_BARST))[threadIdx.x] = 0u;
    if (threadIdx.x == 0) (void)xb_add((unsigned*)(a.ws + WS_CTL) + CW_BAR + XB_XCNT(xb_xcc_id()), 1u);
    __syncthreads();
    bool first = true;
#pragma unroll 1
    for (int ph = a.ph_lo; ph < a.ph_hi; ++ph) {
        if (phase_empty(ph)) continue;
#ifdef REPEAT_MASK
        for (int rep = ((REPEAT_MASK >> ph) & 1ull) ? 1 : 0; rep >= 0; --rep) {
#else
        {
#endif
        int tid = threadIdx.x; asm volatile("" : "+v"(tid));
        tab_t inp = (tab_t)__builtin_amdgcn_kernarg_segment_ptr(); asm volatile("" : "+s"(inp));
        unsigned char* ws = (unsigned char*)(__attribute__((address_space(1))) unsigned char*)inp[N_IN + 1]; float* out = (float*)(__attribute__((address_space(1))) float*)inp[N_IN];
        if (!first) xcd_barrier((unsigned*)(ws + WS_CTL) + CW_BAR, (volatile LAS unsigned*)((LAS char*)lds_raw + LDS_BARST));
        first = false;
        Ctx C; C.lds = (LAS char*)lds_raw; C.tid = tid; C.lane = 0; C.wave = 0; C.fr = 0; C.fq = 0;
        C.G = gridDim.x; C.bid = blockIdx.x; C.in = inp; C.out = out; C.ws = ws;
        float* XSS = WSP(float, WS_XSS); bf16_t* XB = WSP(bf16_t, WS_XB);
        const int kb = (C.bid >> 3) & 3;
        if (ph == 0) { phase_prologue(C); } else {
        const int L = (ph - 1) >> 3, loc = (ph - 1) & 7, kind = L % 3, j = L / 3;
        if (loc == 0) {
            pg8::StaticOrder S;
            if (kind == 0) { pg8::Gemm g{XB, WSP(bf16_t, WS_WAI) + (size_t)j * AFF * DM, MP, AFF, DM}; S.init(MP, AFF, C.G, C.bid);
                pg8::EpiAIn E{WSP(bf16_t, WS_UV), XSS, WSP(float, WS_VSS)}; _Pragma("unroll 1") for (int st2 = 0; st2 < 3; ++st2) { int tid2 = C.tid; asm volatile("" : "+v"(tid2)); if (st2 == 1) { pg8::gemm_phase<pg8::EpiAIn, pg8::StaticOrder, true, true>((LAS unsigned char*)C.lds, g, S, E, tid2); } else { sg::SEpiAIn SE{WSP(bf16_t, WS_UV), XSS, WSP(float, WS_VSS)}; sg::sgemm_phase(C.lds, g.A, g.Bt, AFF, DM, AFF, SE, tid2, C.bid, C.G, st2 == 0 ? 0 : kb, st2 == 0 ? kb : 1000); } } }
            else if (kind == 1) { pg8::Gemm g{XB, WSP(bf16_t, WS_WQKV), MP, NQKV, DM}; S.init(MP, NQKV, C.G, C.bid);
                pg8::EpiQKV E{WSP(bf16_t, WS_QKV), XSS, GIN(I_BQN), GIN(I_BKN)}; _Pragma("unroll 1") for (int st2 = 0; st2 < 3; ++st2) { int tid2 = C.tid; asm volatile("" : "+v"(tid2)); if (st2 == 1) { pg8::gemm_phase<pg8::EpiQKV, pg8::StaticOrder, true, true>((LAS unsigned char*)C.lds, g, S, E, tid2); } else { sg::SEpiQKV SE{WSP(bf16_t, WS_QKV), XSS, GIN(I_BQN), GIN(I_BKN)}; sg::sgemm_phase(C.lds, g.A, g.Bt, NQKV, DM, NQKV, SE, tid2, C.bid, C.G, st2 == 0 ? 0 : (kb & 1), st2 == 0 ? (kb & 1) : 1000, 0, 0, 1); } } }
            else { pg8::Gemm g{XB, WSP(bf16_t, WS_WCI), MP, CDI + CXBC, DM}; S.init(MP, CDI + CXBC, C.G, C.bid);
                pg8::EpiCIn E{WSP(bf16_t, WS_Z), WSP(bf16_t, WS_XBCR), WSP(float, WS_DT), XSS, GIN(I_CDTB)}; _Pragma("unroll 1") for (int st2 = 0; st2 < 3; ++st2) { int tid2 = C.tid; asm volatile("" : "+v"(tid2)); if (st2 == 1) { pg8::gemm_phase<pg8::EpiCIn, pg8::StaticOrder, true, true>((LAS unsigned char*)C.lds, g, S, E, tid2); } else { sg::SEpiCIn SE{WSP(bf16_t, WS_Z), WSP(bf16_t, WS_XBCR), WSP(float, WS_DT), XSS, GIN(I_CDTB)}; sg::sgemm_phase(C.lds, g.A, g.Bt, CINP, DM, 5120, SE, tid2, C.bid, C.G, st2 == 0 ? 0 : kb, st2 == 0 ? kb : 1000, MP / 64 + 8, 80); } } }
        } else if (loc == 1) {
            if (kind == 0) phase_spatial(C, j); else if (kind == 1) phase_attn(C);
        } else if (loc == 2) { phase_states(C);
        } else if (loc == 3) { phase_scan(C);
        } else if (loc == 4) { phase_ssdy(C);
        } else if (loc == 6) {
            pg8::Gemm g{XB, WSP(bf16_t, WS_WUP) + (size_t)L * FF * DM, MP, FF, DM}; pg8::StaticOrder S; S.init(MP, FF, C.G, C.bid);
            pg8::EpiUp E{WSP(bf16_t, WS_H), XSS}; _Pragma("unroll 1") for (int st2 = 0; st2 < 3 + SREP_UP; ++st2) { int tid2 = C.tid; asm volatile("" : "+v"(tid2)); if (st2 == 1) { pg8::gemm_phase<pg8::EpiUp, pg8::StaticOrder, true, true>((LAS unsigned char*)C.lds, g, S, E, tid2); } else { sg::SEpiUp SE{WSP(bf16_t, WS_H), XSS}; sg::sgemm_phase(C.lds, g.A, g.Bt, FF, DM, FF, SE, tid2, C.bid, C.G, st2 == 0 ? 0 : (st2 == 3 ? 0 : kb), st2 == 0 ? kb : 1000); } }
        } else if (loc == 5 && kind == 2) {
            pg8::Gemm g{WSP(bf16_t, WS_YG), WSP(bf16_t, WS_WCO), MP, DM, CDI};
            pg8::EpiResG E{nullptr, C.ws, WSP(float, WS_GRS)};
            pg8::StaticOrder S; S.init(MP, DM, C.G, C.bid);
            _Pragma("unroll 1") for (int st2 = 0; st2 < 3; ++st2) { int tid2 = C.tid; asm volatile("" : "+v"(tid2)); if (st2 == 1) { pg8::gemm_phase<pg8::EpiResG, pg8::StaticOrder, true, true>((LAS unsigned char*)C.lds, g, S, E, tid2); } else { sg::SEpiResG SE{nullptr, C.ws, WSP(float, WS_GRS)}; sg::sgemm32_phase(C.lds, g.A, g.Bt, CDI, SE, tid2, C.bid, C.G, st2 == 0 ? 0 : (kb & 1), st2 == 0 ? (kb & 1) : 1000); } }
        } else {
            pg8::Gemm g; g.M = MP; g.N = DM;
            if (loc == 7) { g.A = WSP(bf16_t, WS_H); g.Bt = WSP(bf16_t, WS_WDN) + (size_t)L * DM * FF; g.K = FF; }
            else if (kind == 0) { g.A = WSP(bf16_t, WS_GATED); g.Bt = WSP(bf16_t, WS_WAO) + (size_t)j * DM * AH; g.K = AH; }
            else { g.A = WSP(bf16_t, WS_O); g.Bt = WSP(bf16_t, WS_WBO); g.K = DM; }
            float* Yout = (L == 3 && loc == 7) ? C.out : nullptr;
            pg8::EpiRes E{Yout, C.ws, nullptr};
            pg8::StaticOrder S; S.init(MP, DM, C.G, C.bid);
            _Pragma("unroll 1") for (int st2 = 0; st2 < 3; ++st2) { int tid2 = C.tid; asm volatile("" : "+v"(tid2)); if (st2 == 1) { pg8::gemm_phase<pg8::EpiRes, pg8::StaticOrder, true, true>((LAS unsigned char*)C.lds, g, S, E, tid2); } else { sg::SEpiRes SE{Yout, C.ws, nullptr}; sg::sgemm32_phase(C.lds, g.A, g.Bt, g.K, SE, tid2, C.bid, C.G, st2 == 0 ? 0 : (kb & 1), st2 == 0 ? (kb & 1) : 1000); } }
        }
        }
        }
    }
}

#ifndef PROBE_LO
#define PROBE_LO 0
#define PROBE_HI 0
#define PROBE_ALPHA 1.0f
#endif
#ifndef N_LAUNCH_MODE
#define N_LAUNCH_MODE 0
#endif
__global__ void k_probe(float* out, size_t lo, size_t hi, float alpha, size_t n) {
    for (size_t i = (size_t)blockIdx.x * blockDim.x + threadIdx.x; i < n; i += (size_t)gridDim.x * blockDim.x) out[i] = (i >= lo && i < hi) ? out[i] * alpha : 0.f;
}
extern "C" void kernel_launch(void* const* d_in, const int* in_sizes, int n_in, void* d_out, int out_size, void* d_ws, size_t ws_size, hipStream_t stream) {
    static int grid = 0;
    if (grid == 0) {
        if (n_in != N_IN || (size_t)out_size != O_TOTAL || ws_size < WS_NEED) { fprintf(stderr, "kernel_launch: unexpected problem (n_in %d, out %d, ws %zu)\n", n_in, out_size, ws_size); grid = -1; return; }
        int dev = 0, cus = 0;
        if (hipGetDevice(&dev) != hipSuccess || hipDeviceGetAttribute(&cus, hipDeviceAttributeMultiprocessorCount, dev) != hipSuccess) { grid = -1; return; }
        if (hipFuncSetAttribute((const void*)fwd, hipFuncAttributeMaxDynamicSharedMemorySize, LDS_BYTES) != hipSuccess) { fprintf(stderr, "kernel_launch: hipFuncSetAttribute failed\n"); grid = -1; return; }
        (void)hipGetLastError();
        grid = cus > 0 ? cus : 256;
    }
    if (grid < 0) return;
    Args a{};
    for (int i = 0; i < N_IN; ++i) a.in[i] = (const float*)d_in[i];
    a.out = (float*)d_out; a.ws = (unsigned char*)d_ws;
    if (hipMemsetAsync((char*)d_ws + WS_CTL, 0, CTL_BYTES, stream) != hipSuccess) return;
    if (N_LAUNCH_MODE == 0) { a.ph_lo = 0; a.ph_hi = N_PHASES; hipLaunchKernelGGL(fwd, dim3(grid), dim3(512), LDS_BYTES, stream, a); }
    else for (int ph = 0; ph < N_PHASES; ++ph) { if (phase_empty(ph)) continue; a.ph_lo = ph; a.ph_hi = ph + 1; hipLaunchKernelGGL(fwd, dim3(grid), dim3(512), LDS_BYTES, stream, a); }
    if (PROBE_HI > PROBE_LO) hipLaunchKernelGGL(k_probe, dim3(2048), dim3(256), 0, stream, (float*)d_out, (size_t)(PROBE_LO), (size_t)(PROBE_HI), (float)(PROBE_ALPHA), (size_t)O_TOTAL);
}
```

```cpp
#include <hip/hip_runtime.h>
#include <cstdio>
#include <cstdint>

#define LAS __attribute__((address_space(3)))
typedef unsigned short bf16_t;
typedef short bf16x8 __attribute__((ext_vector_type(8)));
typedef short s16x4 __attribute__((ext_vector_type(4)));
typedef short v4i16_t __attribute__((ext_vector_type(4)));
typedef float f32x4 __attribute__((ext_vector_type(4)));
typedef float f32x2 __attribute__((ext_vector_type(2)));
typedef unsigned u32x4 __attribute__((ext_vector_type(4)));
typedef unsigned u32x2 __attribute__((ext_vector_type(2)));
typedef __bf16 bf16v2_t __attribute__((ext_vector_type(2)));

constexpr int MP = 16384, MS = 512, MT = MP + MS;
constexpr int DM = 1024, FF = 4096, AFF = 6144, AH = 3072, NQKV = 1536, CIN = 5152, CINP = 5376, CDI = 2048, CXBC = 3072;
constexpr float EPS = 1e-6f;
enum { I_XP = 0, I_XS, I_CK, I_CV, I_SSM, I_CONV, I_NMIX, I_NMLP, I_WUP, I_WDN, I_AWIN, I_ANV, I_AWSP, I_ABSP, I_AWOUT, I_BQKV, I_BQN, I_BKN, I_BSINK, I_RELB, I_BWO,
       I_CWIN, I_CCW, I_CCB, I_CDTB, I_CALOG, I_CD, I_CNORM, I_CWO, N_IN };
constexpr size_t O_Y = 0, O_CV = 17301504, O_KP = 20447232, O_VP = 20578304, O_KS = 20709376, O_VS = 24903680, O_SSMP = 29097984, O_CONVP = 30146560,
                 O_SSMS = 30183424, O_CONVS = 63737856, O_TOTAL = 64917504;
constexpr size_t MiB = 1u << 20;
constexpr size_t WS_CTL = 0, WS_XSS = 1 * MiB, WS_VSS = 3 * MiB, WS_DT = 7 * MiB, WS_ACS = 10 * MiB, WS_CDEC = 13 * MiB, WS_GRS = 14 * MiB;
constexpr size_t WS_WUP = 16 * MiB, WS_WDN = 48 * MiB, WS_WAI = 80 * MiB, WS_WAO = 104 * MiB, WS_WQKV = 116 * MiB, WS_WBO = 119 * MiB, WS_WCI = 121 * MiB, WS_WCO = 132 * MiB;
constexpr size_t WS_XB = 136 * MiB;
constexpr size_t WS_UV = 170 * MiB, WS_GATED = 368 * MiB, WS_H = 170 * MiB, WS_QKV = 170 * MiB, WS_O = 368 * MiB;
constexpr size_t WS_Z = 170 * MiB, WS_XBCR = 236 * MiB, WS_HPREV = 236 * MiB, WS_XBCC = 336 * MiB, WS_CSAVE = 340 * MiB, WS_STATES = 360 * MiB, WS_YG = 436 * MiB;
constexpr size_t WS_NEED = 512 * MiB;

struct Args { const float* in[N_IN]; float* out; unsigned char* ws; int ph_lo, ph_hi; };

__device__ __forceinline__ float bf2f(unsigned h) { return __uint_as_float(h << 16); }
__device__ __forceinline__ unsigned pk2(float lo, float hi) { f32x2 v = {lo, hi}; bf16v2_t b = __builtin_convertvector(v, bf16v2_t); return __builtin_bit_cast(unsigned, b); }
__device__ __forceinline__ u32x2 pk4(f32x4 v) { u32x2 r; r.x = pk2(v[0], v[1]); r.y = pk2(v[2], v[3]); return r; }
__device__ __forceinline__ f32x4 unpk4(u32x2 w) { f32x4 r; r[0] = bf2f(w.x & 0xffffu); r[1] = bf2f(w.x >> 16); r[2] = bf2f(w.y & 0xffffu); r[3] = bf2f(w.y >> 16); return r; }
__device__ __forceinline__ float sq4(f32x4 a) { return (a[0] * a[0] + a[1] * a[1]) + (a[2] * a[2] + a[3] * a[3]); }
__device__ __forceinline__ u32x4 pk8(f32x4 a, f32x4 b) { u32x4 w; w.x = pk2(a[0], a[1]); w.y = pk2(a[2], a[3]); w.z = pk2(b[0], b[1]); w.w = pk2(b[2], b[3]); return w; }
__device__ __forceinline__ float silu_f(float x) { return x * __builtin_amdgcn_rcpf(1.0f + __builtin_amdgcn_exp2f(x * -1.4426950408889634f)); }
__device__ __forceinline__ float wave_sum(float v) {
#pragma unroll
    for (int o = 1; o < 64; o <<= 1) v += __shfl_xor(v, o);
    return v;
}
__device__ __forceinline__ float wave_max(float v) {
#pragma unroll
    for (int o = 1; o < 64; o <<= 1) v = fmaxf(v, __shfl_xor(v, o));
    return v;
}
template <class T> __device__ __forceinline__ T ntl(const T* p) { return __builtin_nontemporal_load(p); }
template <class T> __device__ __forceinline__ void nts(T v, T* p) { __builtin_nontemporal_store(v, p); }
#define LDS_WAIT() asm volatile("s_waitcnt lgkmcnt(0)" ::: "memory")
__device__ __forceinline__ s16x4 tr4(LAS const char* p) { return __builtin_bit_cast(s16x4, __builtin_amdgcn_ds_read_tr16_b64_v4i16((LAS v4i16_t*)p)); }
__device__ __forceinline__ bf16x8 tr_frag(LAS const char* tile, int pitch, int klo, int khi, int n0, int lane) {
    const int i = lane & 15, q = i >> 2, p = i & 3;
    const s16x4 lo = tr4(tile + (klo + q) * pitch + (n0 + 4 * p) * 2);
    const s16x4 hi = tr4(tile + (khi + q) * pitch + (n0 + 4 * p) * 2);
    return (bf16x8){lo[0], lo[1], lo[2], lo[3], hi[0], hi[1], hi[2], hi[3]};
}
__device__ __forceinline__ bf16x8 tr_frag_b(LAS const char* lb, int hi_off, int n0) {
    const s16x4 lo = tr4(lb + n0 * 2);
    const s16x4 hi = tr4(lb + hi_off + n0 * 2);
    return (bf16x8){lo[0], lo[1], lo[2], lo[3], hi[0], hi[1], hi[2], hi[3]};
}
#define TR_LANE_OFF(lane, pitch) ((((lane) & 15) >> 2) * (pitch) + ((lane) & 3) * 8)
#define MFMA16(a, b, c) __builtin_amdgcn_mfma_f32_16x16x32_bf16((a), (b), (c), 0, 0, 0)
namespace pg8 {
constexpr int BM = 256, BK = 64, HALF = 128, HTB = HALF * BK * 2  , STAGE_BYTES = 8 * HTB, NXCD = 8, WGM = 8;
__host__ __device__ __forceinline__ int lds_byte(int r, int c) { const int st = (r >> 4) * 2 + (c >> 5), rr = r & 15, cc = c & 31, ob = rr * 64 + cc * 2; return st * 1024 + (ob ^ (((ob >> 9) & 1) << 5)); }
__host__ __device__ __forceinline__ void stage_rc(int b, int& R, int& C) { const int st = b / 1024, sb = b % 1024, swz = sb ^ (((sb >> 9) & 1) << 5); R = (st >> 1) * 16 + swz / 64; C = (st & 1) * 32 + (swz % 64) / 2; }
__host__ __device__ __forceinline__ int perm32(int rho) { const int n = rho >> 4, i = rho & 15; return 8 * (i >> 2) + 4 * n + (i & 3); }

struct Unit { int pm, pn; };
struct Gemm { const bf16_t* A; const bf16_t* Bt; int M, N, K; };

struct StaticOrder {
    int nM, nN, nwg, G, c;
    __host__ __device__ void init(int M, int N, int G_, int c_) { nM = M / BM; nN = N / BM; nwg = nM * nN; G = G_; c = c_; }
    __host__ __device__ bool next(int i, Unit& u) const {
        const long L = (long)i * G + c; if (L >= nwg) return false;
        int wgid = (int)L; { const int q = nwg / NXCD, r = nwg % NXCD, xcd = wgid % NXCD, off = wgid / NXCD; wgid = (xcd < r ? xcd * (q + 1) : r * (q + 1) + (xcd - r) * q) + off; }
        const int nig = WGM * nN, gid = wgid / nig, fm = gid * WGM, gsz = (nM - fm) < WGM ? (nM - fm) : WGM;
        u.pm = fm + ((wgid % nig) % gsz); u.pn = (wgid % nig) / gsz; return true;
    }
    __device__ __forceinline__ void a_ready(const Unit&) const {}
    __device__ __forceinline__ void done(const Unit&) const {}
};

__device__ __forceinline__ f32x2 gelu_pk(f32x2 v) {
    const f32x2 av = __builtin_elementwise_abs(v), d = av * 0.2316418882f + 1.0f;
    f32x2 t; t.x = __builtin_amdgcn_rcpf(d.x); t.y = __builtin_amdgcn_rcpf(d.y);
    f32x2 q = t * 0.5307027145f + (-0.7265760135f); q = q * t + 0.7107068705f; q = q * t + (-0.142248368f); q = q * t + 0.127414796f; q = q * t;
    const f32x2 s = (v * v) * (-0.72134752044f);
    f32x2 e; e.x = __builtin_amdgcn_exp2f(s.x); e.y = __builtin_amdgcn_exp2f(s.y);
    const f32x2 m = v * (q * e), r = v - m;
    f32x2 o; o.x = v.x < 0.f ? m.x : r.x; o.y = v.y < 0.f ? m.y : r.y; return o;
}

template <class Epi, class Sched, bool ALIGN_EPI = false, bool SP2 = false>
__device__ __forceinline__ void gemm_phase(LAS unsigned char* lds, const Gemm g, const Sched& S, const Epi& E, const int tid) {
    const int wid = __builtin_amdgcn_readfirstlane(tid >> 6), lane = tid & 63, wr = wid >> 2, wc = wid & 3, fr = lane & 15, fq = lane >> 4;
    const int K = g.K, nt = K / BK;
    unsigned voffA[2], voffB[2];
#pragma unroll
    for (int i = 0; i < 2; ++i) { int R, C; stage_rc(tid * 16 + i * 8192, R, C);
        const int Rb = Epi::BMODE == 0 ? R : (Epi::BMODE == 1 ? ((R & ~31) + perm32(R & 31)) : (64 * (R >> 5) + perm32(R & 31)));
        voffA[i] = (unsigned)(R * K + C) * 2u; voffB[i] = (unsigned)(Rb * K + C) * 2u; }
    const size_t kstep = (size_t)(BK * 2);
    const size_t hstep = (size_t)HALF * K * 2;
    const size_t hstepB = (size_t)(Epi::BMODE == 2 ? 32 : HALF) * K * 2;
    const size_t tstep = 2 * hstep;
    const unsigned ldsw = (unsigned)wid * 1024u;
    const int aoff = lds_byte(wr * 64 + fr, fq * 8), boff = lds_byte(wc * 32 + fr, fq * 8);
#define PG8_SA(b, h) (((b) * 2 + (h)) * HTB)
#define PG8_SB(b, h) ((4 + (b) * 2 + (h)) * HTB)
#define PG8_STAGE(bufoff, gbase, voff) do { _Pragma("unroll") for (int _i = 0; _i < 2; ++_i) \
        __builtin_amdgcn_global_load_lds((const unsigned*)((const char*)(gbase) + (voff)[_i]), (LAS unsigned*)(lds + (bufoff) + ldsw + _i * 8192), 16, 0, 0); } while (0)
#define PG8_LDA(dst, b, h) do { _Pragma("unroll") for (int m = 0; m < 4; ++m) _Pragma("unroll") for (int k = 0; k < 2; ++k) dst[m][k] = *(const LAS bf16x8*)(lds + PG8_SA(b, h) + aoff + m * 2048 + k * 1024); } while (0)
#define PG8_LDB(dst, b, h) do { _Pragma("unroll") for (int n = 0; n < 2; ++n) _Pragma("unroll") for (int k = 0; k < 2; ++k) dst[n][k] = *(const LAS bf16x8*)(lds + PG8_SB(b, h) + boff + n * 2048 + k * 1024); } while (0)
#define PG8_MMA(ai, bj, At, Bt) do { __builtin_amdgcn_s_setprio(1); _Pragma("unroll") for (int m = 0; m < 4; ++m) _Pragma("unroll") for (int n = 0; n < 2; ++n) _Pragma("unroll") for (int k = 0; k < 2; ++k) \
        acc[ai][bj][m][n] = __builtin_amdgcn_mfma_f32_16x16x32_bf16(Bt[n][k], At[m][k], acc[ai][bj][m][n], 0, 0, 0); __builtin_amdgcn_s_setprio(0); } while (0)
#define PG8_WAIT_V(n) asm volatile("s_waitcnt vmcnt(" #n ")" ::: "memory")
#define PG8_WAIT_L(n) asm volatile("s_waitcnt lgkmcnt(" #n ")" ::: "memory")
#define PG8_BAR __builtin_amdgcn_s_barrier()
#define PG8_SCHED __builtin_amdgcn_sched_barrier(0)
    Unit cur, nxt; int ui = 0;
    if (!S.next(0, cur)) return;
    E.prepare(S, lds, tid);
    f32x4 acc[2][2][4][2];
#pragma unroll
    for (int a = 0; a < 2; ++a)
#pragma unroll
        for (int b = 0; b < 2; ++b)
#pragma unroll
            for (int m = 0; m < 4; ++m)
#pragma unroll
                for (int n = 0; n < 2; ++n) acc[a][b][m][n] = (f32x4){0.f, 0.f, 0.f, 0.f};
    bf16x8 At[4][2], B0[2][2], B1[2][2];
    const char* cA = (const char*)g.A + (size_t)cur.pm * tstep; const char* cB = (const char*)g.Bt + (size_t)cur.pn * tstep;
    S.a_ready(cur);
    if constexpr (SP2) {
        PG8_STAGE(PG8_SB(0, 0), cB, voffB); PG8_STAGE(PG8_SB(0, 1), cB + hstepB, voffB); PG8_STAGE(PG8_SA(0, 0), cA, voffA); PG8_STAGE(PG8_SA(0, 1), cA + hstep, voffA);
        if (wr == 1) PG8_BAR;
        PG8_WAIT_V(2); PG8_BAR;
        PG8_STAGE(PG8_SB(1, 0), cB + kstep, voffB); PG8_STAGE(PG8_SA(1, 0), cA + kstep, voffA); PG8_STAGE(PG8_SB(1, 1), cB + hstepB + kstep, voffB);
        PG8_WAIT_V(6); PG8_BAR;
    } else {
        PG8_STAGE(PG8_SB(0, 0), cB, voffB); PG8_STAGE(PG8_SA(0, 0), cA, voffA); PG8_STAGE(PG8_SB(0, 1), cB + hstepB, voffB); PG8_STAGE(PG8_SA(0, 1), cA + hstep, voffA);
        if (wr == 1) PG8_BAR;
        PG8_WAIT_V(4); PG8_BAR;
        PG8_STAGE(PG8_SB(1, 0), cB + kstep, voffB); PG8_STAGE(PG8_SA(1, 0), cA + kstep, voffA); PG8_STAGE(PG8_SB(1, 1), cB + hstepB + kstep, voffB);
        PG8_WAIT_V(6); PG8_BAR;
    }
    for (;;) {
        const bool has_next = S.next(ui + 1, nxt);
        const char* nA = has_next ? (const char*)g.A + (size_t)nxt.pm * tstep : cA; const char* nB = has_next ? (const char*)g.Bt + (size_t)nxt.pn * tstep : cB;
        for (int t = 0; t < nt; t += 2) {
            const bool last = (t == nt - 2);
            const char* a1 = cA + (size_t)(t + 1) * kstep;
            const char* a2 = last ? nA : cA + (size_t)(t + 2) * kstep; const char* b2 = last ? nB : cB + (size_t)(t + 2) * kstep;
            const char* a3 = a2 + kstep; const char* b3 = b2 + kstep;
            if (last && has_next) S.a_ready(nxt);
            if constexpr (SP2) {
            PG8_LDB(B0, 0, 0); PG8_LDB(B1, 0, 1); PG8_SCHED; PG8_LDA(At, 0, 0); PG8_STAGE(PG8_SA(1, 1), a1 + hstep, voffA);
            PG8_WAIT_V(8); PG8_WAIT_L(0); PG8_BAR; PG8_MMA(0, 0, At, B0); PG8_MMA(0, 1, At, B1); PG8_BAR; PG8_SCHED;
            PG8_LDA(At, 0, 1); PG8_STAGE(PG8_SB(0, 0), b2, voffB); PG8_STAGE(PG8_SB(0, 1), b2 + hstepB, voffB); PG8_STAGE(PG8_SA(0, 0), a2, voffA);
            PG8_WAIT_V(8); PG8_WAIT_L(0); PG8_BAR; PG8_MMA(1, 0, At, B0); PG8_MMA(1, 1, At, B1); PG8_BAR; PG8_SCHED;
            PG8_LDB(B0, 1, 0); PG8_LDB(B1, 1, 1); PG8_SCHED; PG8_LDA(At, 1, 0); PG8_STAGE(PG8_SA(0, 1), a2 + hstep, voffA);
            PG8_WAIT_V(8); PG8_WAIT_L(0); PG8_BAR; PG8_MMA(0, 0, At, B0); PG8_MMA(0, 1, At, B1); PG8_BAR; PG8_SCHED;
            PG8_LDA(At, 1, 1); PG8_STAGE(PG8_SB(1, 0), b3, voffB); PG8_STAGE(PG8_SB(1, 1), b3 + hstepB, voffB); PG8_STAGE(PG8_SA(1, 0), a3, voffA);
            PG8_WAIT_V(8); PG8_WAIT_L(0); PG8_BAR; PG8_MMA(1, 0, At, B0); PG8_MMA(1, 1, At, B1); PG8_BAR; PG8_SCHED;
            } else {
            PG8_LDB(B0, 0, 0); PG8_SCHED; PG8_LDA(At, 0, 0); PG8_STAGE(PG8_SA(1, 1), a1 + hstep, voffA);
            PG8_WAIT_L(8); PG8_BAR; PG8_WAIT_L(0); PG8_MMA(0, 0, At, B0); PG8_BAR; PG8_SCHED;
            PG8_LDB(B1, 0, 1); PG8_STAGE(PG8_SB(0, 0), b2, voffB);
            PG8_BAR; PG8_WAIT_L(0); PG8_MMA(0, 1, At, B1); PG8_BAR;
            PG8_LDA(At, 0, 1); PG8_STAGE(PG8_SA(0, 0), a2, voffA);
            PG8_BAR; PG8_WAIT_L(0); PG8_MMA(1, 0, At, B0); PG8_BAR; PG8_SCHED;
            PG8_STAGE(PG8_SB(0, 1), b2 + hstepB, voffB);
            PG8_WAIT_V(6); PG8_BAR; PG8_MMA(1, 1, At, B1); PG8_BAR;
            PG8_LDB(B0, 1, 0); PG8_SCHED; PG8_LDA(At, 1, 0); PG8_STAGE(PG8_SA(0, 1), a2 + hstep, voffA);
            PG8_WAIT_L(8); PG8_BAR; PG8_WAIT_L(0); PG8_MMA(0, 0, At, B0); PG8_BAR; PG8_SCHED;
            PG8_LDB(B1, 1, 1); PG8_STAGE(PG8_SB(1, 0), b3, voffB);
            PG8_BAR; PG8_WAIT_L(0); PG8_MMA(0, 1, At, B1); PG8_BAR;
            PG8_LDA(At, 1, 1); PG8_STAGE(PG8_SA(1, 0), a3, voffA);
            PG8_BAR; PG8_WAIT_L(0); PG8_MMA(1, 0, At, B0); PG8_BAR; PG8_SCHED;
            PG8_STAGE(PG8_SB(1, 1), b3 + hstepB, voffB);
            PG8_WAIT_V(6); PG8_BAR; PG8_MMA(1, 1, At, B1); PG8_BAR;
            }
            if constexpr (Epi::KSCALE) { if (((t + 2) & 7) == 0 && t + 2 < nt) E.kscale(acc, ((t + 2) >> 3) - 1, ui, lds, wr, fr); }
        }
        if constexpr (ALIGN_EPI) { if (wr == 0) PG8_BAR; }
        E(acc, cur, wr, wc, fr, fq, ui, lds); S.done(cur);
        if (!has_next) break;
#pragma unroll
        for (int a = 0; a < 2; ++a)
#pragma unroll
            for (int b = 0; b < 2; ++b)
#pragma unroll
                for (int m = 0; m < 4; ++m)
#pragma unroll
                    for (int n = 0; n < 2; ++n) acc[a][b][m][n] = (f32x4){0.f, 0.f, 0.f, 0.f};
        cur = nxt; cA = nA; cB = nB; ++ui;
        if constexpr (ALIGN_EPI) { if (wr == 1) PG8_BAR; }
    }
    PG8_WAIT_V(0);
    if constexpr (!ALIGN_EPI) { if (wr == 0) PG8_BAR; }
    PG8_BAR;
#undef PG8_SA
#undef PG8_SB
#undef PG8_STAGE
#undef PG8_LDA
#undef PG8_LDB
#undef PG8_MMA
#undef PG8_WAIT_V
#undef PG8_WAIT_L
#undef PG8_BAR
#undef PG8_SCHED
}

typedef f32x4 AccT[2][2][4][2];
constexpr int RS_OFF = 131072;
template <class Sched> __device__ __forceinline__ void rs_prepare(const float* XSS, const Sched& S, LAS unsigned char* lds, int tid) {
    LAS float* rsL = (LAS float*)(lds + RS_OFF); Unit u;
    int n = 0; while (S.next(n, u)) ++n;
    f32x4 v[3][4];
#pragma unroll
    for (int k = 0; k < 3; ++k) { const int idx = tid + 512 * k;
        if (idx < n * 256) { S.next(idx >> 8, u); const f32x4* p = (const f32x4*)(XSS + (size_t)(u.pm * BM + (idx & 255)) * 16); v[k][0] = p[0]; v[k][1] = p[1]; v[k][2] = p[2]; v[k][3] = p[3]; } }
#pragma unroll
    for (int k = 0; k < 3; ++k) { const int idx = tid + 512 * k;
        if (idx < n * 256) { const f32x4 a = v[k][0], b = v[k][1], c = v[k][2], d = v[k][3];
            const float s = ((a[0] + a[1]) + (a[2] + a[3])) + ((b[0] + b[1]) + (b[2] + b[3])) + ((c[0] + c[1]) + (c[2] + c[3])) + ((d[0] + d[1]) + (d[2] + d[3]));
            rsL[idx] = rsqrtf(s * (1.0f / 1024.0f) + EPS); } }
    asm volatile("s_waitcnt lgkmcnt(0)" ::: "memory"); __builtin_amdgcn_s_barrier(); asm volatile("" ::: "memory");
}
__device__ __forceinline__ void rs_get(LAS unsigned char* lds, int ui, int wr, int fr, float (&rs)[2][4]) {
    const LAS float* rsL = (const LAS float*)(lds + RS_OFF) + ui * 256 + wr * 64 + fr;
#pragma unroll
    for (int ai = 0; ai < 2; ++ai)
#pragma unroll
        for (int m = 0; m < 4; ++m) rs[ai][m] = rsL[ai * HALF + m * 16];
}
__device__ __forceinline__ void row_scales(const float* XSS, int row0, int fq, float (&rs)[2][4]) {
#pragma unroll
    for (int ai = 0; ai < 2; ++ai)
#pragma unroll
        for (int m = 0; m < 4; ++m) {
            const f32x4 v = *(const f32x4*)(XSS + (size_t)(row0 + ai * HALF + m * 16) * 16 + 4 * fq);
            float s = (v[0] + v[1]) + (v[2] + v[3]); s += __shfl_xor(s, 16); s += __shfl_xor(s, 32);
            rs[ai][m] = rsqrtf(s * (1.0f / 1024.0f) + EPS);
        }
}

struct EpiAIn {
    static constexpr bool KSCALE = false;
    template <class Sched> __device__ __forceinline__ void prepare(const Sched& S, LAS unsigned char* lds, int tid) const { rs_prepare(XSS, S, lds, tid); }
    static constexpr int BMODE = 1;
    bf16_t* UV; const float* XSS; float* VSS;
    __device__ __forceinline__ void operator()(const AccT& acc, const Unit& u, int wr, int wc, int fr, int fq, int ui, LAS unsigned char* lds) const {
        const int row0 = u.pm * BM + wr * 64 + fr, col0 = u.pn * BM + wc * 32 + 8 * fq;
        float rs[2][4]; rs_get(lds, ui, wr, fr, rs);
        const bool isv = u.pn >= 12;
#pragma unroll
        for (int ai = 0; ai < 2; ++ai)
#pragma unroll
            for (int m = 0; m < 4; ++m) { const int row = row0 + ai * HALF + m * 16; float ss = 0.f; const float r = rs[ai][m];
#pragma unroll
                for (int bj = 0; bj < 2; ++bj) { f32x4 v0 = acc[ai][bj][m][0] * r, v1 = acc[ai][bj][m][1] * r;
                    const f32x2 a = gelu_pk((f32x2){v0[0], v0[1]}), b = gelu_pk((f32x2){v0[2], v0[3]}), c = gelu_pk((f32x2){v1[0], v1[1]}), d = gelu_pk((f32x2){v1[2], v1[3]});
                    v0 = (f32x4){a.x, a.y, b.x, b.y}; v1 = (f32x4){c.x, c.y, d.x, d.y};
                    ss += sq4(v0) + sq4(v1);
                    *(u32x4*)(UV + (size_t)row * AFF + col0 + bj * HALF) = pk8(v0, v1); }
                if (isv) { ss += __shfl_xor(ss, 16); ss += __shfl_xor(ss, 32); if (fq == 0) VSS[(size_t)row * 48 + (u.pn - 12) * 4 + wc] = ss; } }
    }
};
template <bool WITHG> struct EpiResT {
    static constexpr bool KSCALE = WITHG;
    template <class Sched> __device__ __forceinline__ void prepare(const Sched& S, LAS unsigned char* lds, int tid) const {
        if (!WITHG) return;
        LAS float* tb = (LAS float*)(lds + RS_OFF); Unit u;
        for (int i = 0; S.next(i, u); ++i) if (tid < 256) { const f32x4 q = *(const f32x4*)(GRS + (size_t)(u.pm * BM + tid) * 4);
            tb[(i * 4 + 0) * 256 + tid] = q[0] / q[1]; tb[(i * 4 + 1) * 256 + tid] = q[1] / q[2]; tb[(i * 4 + 2) * 256 + tid] = q[2] / q[3]; tb[(i * 4 + 3) * 256 + tid] = q[3]; }
        asm volatile("s_waitcnt lgkmcnt(0)" ::: "memory"); __builtin_amdgcn_s_barrier(); asm volatile("" ::: "memory");
    }
    __device__ __forceinline__ void kscale(AccT& acc, int gdone, int ui, LAS unsigned char* lds, int wr, int fr) const {
        if (!WITHG) return;
        const LAS float* tb = (const LAS float*)(lds + RS_OFF) + (ui * 4 + gdone) * 256 + wr * 64 + fr;
#pragma unroll
        for (int ai = 0; ai < 2; ++ai)
#pragma unroll
            for (int m = 0; m < 4; ++m) { const float f = tb[ai * HALF + m * 16];
#pragma unroll
                for (int bj = 0; bj < 2; ++bj)
#pragma unroll
                    for (int n = 0; n < 2; ++n) acc[ai][bj][m][n] = acc[ai][bj][m][n] * f; }
    }
    static constexpr int BMODE = 1;
    float* Y; unsigned char* ws; const float* GRS;
    __device__ __forceinline__ void operator()(const AccT& acc, const Unit& u, int wr, int wc, int fr, int fq, int ui, LAS unsigned char* lds) const {
        const int row0 = u.pm * BM + wr * 64 + fr, col0 = u.pn * BM + wc * 32 + 8 * fq;
        bf16_t* XB = (bf16_t*)(ws + WS_XB); float* XSS = (float*)(ws + WS_XSS);
        const LAS float* tb = (const LAS float*)(lds + RS_OFF) + (ui * 4 + 3) * 256 + wr * 64 + fr;
#pragma unroll
        for (int ai = 0; ai < 2; ++ai)
#pragma unroll
            for (int m = 0; m < 4; ++m) { const int row = row0 + ai * HALF + m * 16; float ss = 0.f; const size_t off = (size_t)row * DM + col0;
                const float fs = WITHG ? tb[ai * HALF + m * 16] : 1.0f;
                const u32x4 o2[2] = {*(const u32x4*)(XB + off), *(const u32x4*)(XB + off + HALF)};
#pragma unroll
                for (int bj = 0; bj < 2; ++bj) { const u32x4 o = o2[bj];
                    const f32x4 n0 = unpk4((u32x2){o.x, o.y}) + acc[ai][bj][m][0] * fs, n1 = unpk4((u32x2){o.z, o.w}) + acc[ai][bj][m][1] * fs;
                    *(u32x4*)(XB + off + bj * HALF) = pk8(n0, n1);
                    if (Y) { nts(n0, (f32x4*)(Y + off + bj * HALF)); nts(n1, (f32x4*)(Y + off + bj * HALF + 4)); }
                    ss += sq4(n0) + sq4(n1); }
                ss += __shfl_xor(ss, 16); ss += __shfl_xor(ss, 32); if (fq == 0) XSS[(size_t)row * 16 + u.pn * 4 + wc] = ss;
                asm volatile("" ::: "memory"); }
    }
};
typedef EpiResT<false> EpiRes;
typedef EpiResT<true> EpiResG;
struct EpiUp {
    static constexpr bool KSCALE = false;
    template <class Sched> __device__ __forceinline__ void prepare(const Sched& S, LAS unsigned char* lds, int tid) const { rs_prepare(XSS, S, lds, tid); }
    static constexpr int BMODE = 1;
    bf16_t* H; const float* XSS;
    __device__ __forceinline__ void operator()(const AccT& acc, const Unit& u, int wr, int wc, int fr, int fq, int ui, LAS unsigned char* lds) const {
        const int row0 = u.pm * BM + wr * 64 + fr, col0 = u.pn * BM + wc * 32 + 8 * fq;
        float rs[2][4]; rs_get(lds, ui, wr, fr, rs);
#pragma unroll
        for (int ai = 0; ai < 2; ++ai)
#pragma unroll
            for (int m = 0; m < 4; ++m) { const int row = row0 + ai * HALF + m * 16; const float r = rs[ai][m];
#pragma unroll
                for (int bj = 0; bj < 2; ++bj) { f32x4 v0 = acc[ai][bj][m][0] * r, v1 = acc[ai][bj][m][1] * r;
#pragma unroll
                    for (int e = 0; e < 4; ++e) { const float a = fmaxf(v0[e], 0.f), b = fmaxf(v1[e], 0.f); v0[e] = a * a; v1[e] = b * b; }
                    *(u32x4*)(H + (size_t)row * FF + col0 + bj * HALF) = pk8(v0, v1);
                    } }
    }
};
struct EpiQKV {
    static constexpr bool KSCALE = false;
    template <class Sched> __device__ __forceinline__ void prepare(const Sched& S, LAS unsigned char* lds, int tid) const { rs_prepare(XSS, S, lds, tid); }
    static constexpr int BMODE = 2;
    bf16_t* QKV; const float* XSS; const float* qn; const float* kn;
    __device__ __forceinline__ void operator()(const AccT& acc, const Unit& u, int wr, int wc, int fr, int fq, int ui, LAS unsigned char* lds) const {
        const int row0 = u.pm * BM + wr * 64 + fr, colh = u.pn * BM + wc * 64;
        float rs[2][4]; rs_get(lds, ui, wr, fr, rs);
        const float* nw = (u.pn < 4) ? qn : kn; const bool donorm = u.pn < 5;
        f32x4 w[2][2];
#pragma unroll
        for (int bj = 0; bj < 2; ++bj)
#pragma unroll
            for (int n = 0; n < 2; ++n) w[bj][n] = donorm ? *(const f32x4*)(nw + bj * 32 + 8 * fq + 4 * n) : (f32x4){1.f, 1.f, 1.f, 1.f};
#pragma unroll
        for (int ai = 0; ai < 2; ++ai)
#pragma unroll
            for (int m = 0; m < 4; ++m) { const int row = row0 + ai * HALF + m * 16; const float r = rs[ai][m];
                f32x4 v[2][2]; float ss = 0.f;
#pragma unroll
                for (int bj = 0; bj < 2; ++bj)
#pragma unroll
                    for (int n = 0; n < 2; ++n) { v[bj][n] = acc[ai][bj][m][n] * r; ss += sq4(v[bj][n]); }
                ss += __shfl_xor(ss, 16); ss += __shfl_xor(ss, 32);
                const float hs = donorm ? rsqrtf(ss * (1.0f / 64.0f) + EPS) : 1.0f;
#pragma unroll
                for (int bj = 0; bj < 2; ++bj)
                    *(u32x4*)(QKV + (size_t)row * NQKV + colh + bj * 32 + 8 * fq) = pk8(v[bj][0] * hs * w[bj][0], v[bj][1] * hs * w[bj][1]); }
    }
};
struct EpiCIn {
    static constexpr bool KSCALE = false;
    template <class Sched> __device__ __forceinline__ void prepare(const Sched& S, LAS unsigned char* lds, int tid) const { rs_prepare(XSS, S, lds, tid); }
    static constexpr int BMODE = 1;
    bf16_t* Z; bf16_t* XBCR; float* DT; const float* XSS; const float* dtb;
    __device__ __forceinline__ void operator()(const AccT& acc, const Unit& u, int wr, int wc, int fr, int fq, int ui, LAS unsigned char* lds) const {
        const int row0 = u.pm * BM + wr * 64 + fr;
        float rs[2][4]; rs_get(lds, ui, wr, fr, rs);
        if (u.pn < 20) {
            bf16_t* base; int ld, col0;
            if (u.pn < 8) { base = Z; ld = CDI; col0 = u.pn * BM + wc * 32 + 8 * fq; } else { base = XBCR; ld = CXBC; col0 = (u.pn - 8) * BM + wc * 32 + 8 * fq; }
#pragma unroll
            for (int ai = 0; ai < 2; ++ai)
#pragma unroll
                for (int m = 0; m < 4; ++m) { const int row = row0 + ai * HALF + m * 16; const float r = rs[ai][m];
#pragma unroll
                    for (int bj = 0; bj < 2; ++bj) *(u32x4*)(base + (size_t)row * ld + col0 + bj * HALF) = pk8(acc[ai][bj][m][0] * r, acc[ai][bj][m][1] * r); }
        } else if (wc == 0) {
            const f32x4 b0 = *(const f32x4*)(dtb + 8 * fq), b1 = *(const f32x4*)(dtb + 8 * fq + 4);
#pragma unroll
            for (int ai = 0; ai < 2; ++ai)
#pragma unroll
                for (int m = 0; m < 4; ++m) { const int row = row0 + ai * HALF + m * 16; const float r = rs[ai][m];
                    f32x4 v0 = acc[ai][0][m][0] * r + b0, v1 = acc[ai][0][m][1] * r + b1;
#pragma unroll
                    for (int e = 0; e < 4; ++e) { v0[e] = v0[e] > 20.f ? v0[e] : log1pf(__expf(v0[e])); v1[e] = v1[e] > 20.f ? v1[e] : log1pf(__expf(v1[e])); }
                    *(f32x4*)(DT + (size_t)row * 32 + 8 * fq) = v0; *(f32x4*)(DT + (size_t)row * 32 + 8 * fq + 4) = v1; }
        }
    }
};
}
namespace sg {
template <class Epi>
__device__ __forceinline__ void sgemm_phase(LAS char* lds, const bf16_t* A, const bf16_t* Bt, int N, int K, int ncols_used, const Epi& E, int tid, int bid, int G, int k_lo, int k_hi, int n_extra = 0, int extra_strip = 0, int mode = 0) {
    const int lane = tid & 63, w = __builtin_amdgcn_readfirstlane(tid >> 6), fr = lane & 15, fq = lane >> 4;
    const int nstrip = ncols_used / 64, Kw = K / 8, nbat = Kw / 64;
    LAS float* red = (LAS float*)lds;
    const unsigned lo = (unsigned)(fr * K + 8 * fq) * 2u, rstep = (unsigned)K * 32u;
    const int xq = bid & 7, jq = bid >> 3, S = nstrip >> 3;
    auto decode = [&](int k, int& row0, int& strip) -> bool {
        if (k >= k_hi) return false;
        int e;
        if (G == 256) {
            int nk;
            if (mode == 0) { nk = (S - (jq & 3) + 3) >> 2; if (k < nk) { row0 = MP + 64 * (jq >> 2); strip = xq * S + (jq & 3) + 4 * k; return true; } }
            else { const int jj = jq - 16; nk = jj < 0 ? 0 : (S - (jj & 1) + 1) >> 1; if (k < nk) { row0 = MP + 64 * (jj >> 1); strip = xq * S + (jj & 1) + 2 * k; return true; } }
            const int ke = k - nk; e = ke == 0 ? bid : (ke == 1 && jq == 3 ? G + xq : n_extra);
        } else {
            const int u = (G - 1 - bid) + k * G, nsamp = 8 * nstrip;
            if (u < nsamp) { row0 = MP + 64 * (u & 7); strip = u >> 3; return true; }
            e = u - nsamp;
        }
        if (e >= n_extra) return false;
        row0 = e < MP / 64 ? 64 * e : MP + 64 * (e - MP / 64); strip = extra_strip; return true;
    };
    bf16x8 a0[2][4], b0[2][4], a1[2][4], b1[2][4];
#define SG_LOAD(fa, fb, kb) do { _Pragma("unroll") for (int s = 0; s < 2; ++s) { _Pragma("unroll") for (int m = 0; m < 4; ++m) fa[s][m] = *(const bf16x8*)(Au + (size_t)(m * rstep) + (size_t)lo + ((kb) + 32 * s) * 2); \
            _Pragma("unroll") for (int n = 0; n < 4; ++n) fb[s][n] = *(const bf16x8*)(Bu + (size_t)(n * rstep) + (size_t)lo + ((kb) + 32 * s) * 2); } } while (0)
#define SG_MMA(fa, fb) do { _Pragma("unroll") for (int s = 0; s < 2; ++s) _Pragma("unroll") for (int m = 0; m < 4; ++m) _Pragma("unroll") for (int n = 0; n < 4; ++n) acc[m][n] = MFMA16(fb[s][n], fa[s][m], acc[m][n]); } while (0)
#define SG_BASES(r0, sp) const char* Au = (const char*)A + ((size_t)(r0) * K + (size_t)w * Kw) * 2; const char* Bu = (const char*)Bt + ((size_t)(64 * (sp)) * K + (size_t)w * Kw) * 2
    int k = k_lo, rowb = 0, st = 0; bool have = decode(k, rowb, st);
    if (have) { SG_BASES(rowb, st); SG_LOAD(a0, b0, 0); }
    while (have) {
        const int erow = rowb + (tid >> 3); float pre = E.pre(erow); f32x4 pl0, pl1; E.preload(erow, 64 * st + (tid & 7) * 8, pl0, pl1);
        f32x4 acc[4][4];
#pragma unroll
        for (int m = 0; m < 4; ++m)
#pragma unroll
            for (int n = 0; n < 4; ++n) acc[m][n] = (f32x4){0.f, 0.f, 0.f, 0.f};
        { SG_BASES(rowb, st);
          for (int b = 0; b < nbat; b += 2) {
            SG_LOAD(a1, b1, 64 * (b + 1));
            SG_MMA(a0, b0);
            if (b + 2 < nbat) SG_LOAD(a0, b0, 64 * (b + 2));
            SG_MMA(a1, b1);
          } }
        asm volatile("" : "+v"(pre), "+v"(pl0), "+v"(pl1));
        int rown = 0, stn = 0; const bool haven = decode(k + 1, rown, stn);
        if (haven) { SG_BASES(rown, stn); SG_LOAD(a0, b0, 0); }
#pragma unroll
        for (int m = 0; m < 4; ++m) { const float f = E.wscale(rowb + 16 * m + fr, w);
#pragma unroll
            for (int n = 0; n < 4; ++n) acc[m][n] = acc[m][n] * f; }
#pragma unroll
        for (int m = 0; m < 4; ++m)
#pragma unroll
            for (int n = 0; n < 4; ++n) *(LAS f32x4*)(red + (w * 64 + 16 * m + fr) * 68 + 16 * n + 4 * fq) = acc[m][n];
        __syncthreads();
        { const int row = tid >> 3, c8 = (tid & 7) * 8; f32x4 s0 = (f32x4){0.f, 0.f, 0.f, 0.f}, s1 = s0;
#pragma unroll
          for (int ww = 0; ww < 8; ++ww) { s0 += *(const LAS f32x4*)(red + (ww * 64 + row) * 68 + c8); s1 += *(const LAS f32x4*)(red + (ww * 64 + row) * 68 + c8 + 4); }
          E.apply(erow, 64 * st + c8, s0, s1, pre, pl0, pl1); }
        __syncthreads();
        ++k; rowb = rown; st = stn; have = haven;
    }
#undef SG_LOAD
#undef SG_MMA
#undef SG_BASES
}
template <class Epi>
__device__ __forceinline__ void sgemm32_phase(LAS char* lds, const bf16_t* A, const bf16_t* Bt, int K, const Epi& E, int tid, int bid, int G, int k_lo, int k_hi) {
    const int lane = tid & 63, w = __builtin_amdgcn_readfirstlane(tid >> 6), fr = lane & 15, fq = lane >> 4;
    const int nunit = 16 * (DM / 64), Kw = K / 8, nbat = Kw / 64;
    LAS float* red = (LAS float*)lds;
    const unsigned lo = (unsigned)(fr * K + 8 * fq) * 2u, rstep = (unsigned)K * 32u;
    bf16x8 a0[2][2], b0[2][4], a1[2][2], b1[2][4], a2[2][2], b2[2][4];
#define SG_LOAD(fa, fb, kb) do { _Pragma("unroll") for (int s = 0; s < 2; ++s) { _Pragma("unroll") for (int m = 0; m < 2; ++m) fa[s][m] = *(const bf16x8*)(Au + (size_t)(m * rstep) + (size_t)lo + ((kb) + 32 * s) * 2); \
            _Pragma("unroll") for (int n = 0; n < 4; ++n) fb[s][n] = *(const bf16x8*)(Bu + (size_t)(n * rstep) + (size_t)lo + ((kb) + 32 * s) * 2); } } while (0)
#define SG_MMA(fa, fb) do { _Pragma("unroll") for (int s = 0; s < 2; ++s) _Pragma("unroll") for (int m = 0; m < 2; ++m) _Pragma("unroll") for (int n = 0; n < 4; ++n) acc[m][n] = MFMA16(fb[s][n], fa[s][m], acc[m][n]); } while (0)
#define SG_BASES(uu) const char* Au = (const char*)A + ((size_t)(MP + 32 * ((uu) & 15)) * K + (size_t)w * Kw) * 2; const char* Bu = (const char*)Bt + ((size_t)(64 * ((uu) >> 4)) * K + (size_t)w * Kw) * 2
    if (G == 256) { const int xq = bid & 7, jq = bid >> 3; bid = 16 * (4 * (xq & 3) + (jq & 3)) + 8 * (xq >> 2) + (jq >> 2); } else bid = G - 1 - bid;
    int u = bid + k_lo * G; const int uend = (bid + k_hi * G < nunit ? bid + k_hi * G : nunit);
    if (u < uend) { SG_BASES(u); SG_LOAD(a0, b0, 0); SG_LOAD(a1, b1, 64); }
    while (u < uend) {
        const int rowb = MP + 32 * (u & 15), st = u >> 4;
        const int erow = rowb + ((tid >> 3) & 31); f32x4 pl0, pl1; E.preload(erow, 64 * st + (tid & 7) * 8, pl0, pl1);
        f32x4 acc[2][4];
#pragma unroll
        for (int m = 0; m < 2; ++m)
#pragma unroll
            for (int n = 0; n < 4; ++n) acc[m][n] = (f32x4){0.f, 0.f, 0.f, 0.f};
        { SG_BASES(u);
          for (int b = 0; b < nbat; b += 3) {
            if (b + 2 < nbat) SG_LOAD(a2, b2, 64 * (b + 2));
            SG_MMA(a0, b0);
            if (b + 1 < nbat) { if (b + 3 < nbat) SG_LOAD(a0, b0, 64 * (b + 3)); SG_MMA(a1, b1); }
            if (b + 2 < nbat) { if (b + 4 < nbat) SG_LOAD(a1, b1, 64 * (b + 4)); SG_MMA(a2, b2); }
          } }
        asm volatile("" : "+v"(pl0), "+v"(pl1));
        const int un = u + G;
        if (un < uend) { SG_BASES(un); SG_LOAD(a0, b0, 0); SG_LOAD(a1, b1, 64); }
#pragma unroll
        for (int m = 0; m < 2; ++m) { const float f = E.wscale(rowb + 16 * m + fr, w);
#pragma unroll
            for (int n = 0; n < 4; ++n) *(LAS f32x4*)(red + (w * 32 + 16 * m + fr) * 68 + 16 * n + 4 * fq) = acc[m][n] * f; }
        __syncthreads();
        if (tid < 256) { const int row = tid >> 3, c8 = (tid & 7) * 8; f32x4 s0 = (f32x4){0.f, 0.f, 0.f, 0.f}, s1 = s0;
#pragma unroll
          for (int ww = 0; ww < 8; ++ww) { s0 += *(const LAS f32x4*)(red + (ww * 32 + row) * 68 + c8); s1 += *(const LAS f32x4*)(red + (ww * 32 + row) * 68 + c8 + 4); }
          E.apply(erow, 64 * st + c8, s0, s1, 0.f, pl0, pl1); }
        __syncthreads();
        u = un;
    }
#undef SG_LOAD
#undef SG_MMA
#undef SG_BASES
}
__device__ __forceinline__ float row8_sum(float v) { v += __shfl_xor(v, 1); v += __shfl_xor(v, 2); v += __shfl_xor(v, 4); return v; }
__device__ __forceinline__ float xss_scale(const float* XSS, int row) {
    const f32x4* p = (const f32x4*)(XSS + (size_t)row * 16); const f32x4 a = p[0], b = p[1], c = p[2], d = p[3];
    const float s = ((a[0] + a[1]) + (a[2] + a[3])) + ((b[0] + b[1]) + (b[2] + b[3])) + ((c[0] + c[1]) + (c[2] + c[3])) + ((d[0] + d[1]) + (d[2] + d[3]));
    return rsqrtf(s * (1.0f / 1024.0f) + EPS);
}
struct SEpiAIn { bf16_t* UV; const float* XSS; float* VSS;
    __device__ __forceinline__ float pre(int row) const { return xss_scale(XSS, row); }
    __device__ __forceinline__ float wscale(int, int) const { return 1.0f; }
    __device__ __forceinline__ void preload(int, int, f32x4& p0, f32x4& p1) const { p0 = p1 = (f32x4){0.f, 0.f, 0.f, 0.f}; }
    __device__ __forceinline__ void apply(int row, int col0, f32x4 s0, f32x4 s1, float r, f32x4, f32x4) const {
        s0 = s0 * r; s1 = s1 * r;
        const f32x2 a = pg8::gelu_pk((f32x2){s0[0], s0[1]}), b = pg8::gelu_pk((f32x2){s0[2], s0[3]}), c = pg8::gelu_pk((f32x2){s1[0], s1[1]}), d = pg8::gelu_pk((f32x2){s1[2], s1[3]});
        s0 = (f32x4){a.x, a.y, b.x, b.y}; s1 = (f32x4){c.x, c.y, d.x, d.y};
        *(u32x4*)(UV + (size_t)row * AFF + col0) = pk8(s0, s1);
        if (col0 >= AH) { const float ss = row8_sum(sq4(s0) + sq4(s1)); if ((threadIdx.x & 7) == 0) VSS[(size_t)row * 48 + (col0 - AH) / 64] = ss; } }
};
template <bool WITHG> struct SEpiResT { float* Y; unsigned char* ws; const float* GRS;
    __device__ __forceinline__ float pre(int) const { return 0.f; }
    __device__ __forceinline__ float wscale(int row, int w) const { return WITHG ? GRS[(size_t)row * 4 + (w >> 1)] : 1.0f; }
    __device__ __forceinline__ void preload(int row, int col0, f32x4& p0, f32x4& p1) const { p0 = *(const f32x4*)((const bf16_t*)(ws + WS_XB) + (size_t)row * DM + col0); p1 = (f32x4){0.f, 0.f, 0.f, 0.f}; }
    __device__ __forceinline__ void apply(int row, int col0, f32x4 s0, f32x4 s1, float, f32x4 p0, f32x4) const {
        bf16_t* xp = (bf16_t*)(ws + WS_XB) + (size_t)row * DM + col0; const u32x4 o = __builtin_bit_cast(u32x4, p0);
        const f32x4 n0 = unpk4((u32x2){o.x, o.y}) + s0, n1 = unpk4((u32x2){o.z, o.w}) + s1;
        *(u32x4*)xp = pk8(n0, n1);
        if (Y) { float* yp = Y + (size_t)row * DM + col0; *(f32x4*)yp = n0; *(f32x4*)(yp + 4) = n1; }
        const float ss = row8_sum(sq4(n0) + sq4(n1)); if ((threadIdx.x & 7) == 0) ((float*)(ws + WS_XSS))[(size_t)row * 16 + col0 / 64] = ss; }
};
typedef SEpiResT<false> SEpiRes;
typedef SEpiResT<true> SEpiResG;
struct SEpiUp { bf16_t* H; const float* XSS;
    __device__ __forceinline__ float pre(int row) const { return xss_scale(XSS, row); }
    __device__ __forceinline__ float wscale(int, int) const { return 1.0f; }
    __device__ __forceinline__ void preload(int, int, f32x4& p0, f32x4& p1) const { p0 = p1 = (f32x4){0.f, 0.f, 0.f, 0.f}; }
    __device__ __forceinline__ void apply(int row, int col0, f32x4 s0, f32x4 s1, float r, f32x4, f32x4) const {
#pragma unroll
        for (int e = 0; e < 4; ++e) { const float a = fmaxf(s0[e] * r, 0.f), b = fmaxf(s1[e] * r, 0.f); s0[e] = a * a; s1[e] = b * b; }
        *(u32x4*)(H + (size_t)row * FF + col0) = pk8(s0, s1); }
};
struct SEpiQKV { bf16_t* QKV; const float* XSS; const float* qn; const float* kn;
    __device__ __forceinline__ float pre(int row) const { return xss_scale(XSS, row); }
    __device__ __forceinline__ float wscale(int, int) const { return 1.0f; }
    __device__ __forceinline__ void preload(int, int col0, f32x4& p0, f32x4& p1) const { const float* nw = (col0 < 1024 ? qn : kn) + (col0 & 63); p0 = *(const f32x4*)nw; p1 = *(const f32x4*)(nw + 4); }
    __device__ __forceinline__ void apply(int row, int col0, f32x4 s0, f32x4 s1, float r, f32x4 p0, f32x4 p1) const {
        s0 = s0 * r; s1 = s1 * r;
        if (col0 < 1280) { const float ss = row8_sum(sq4(s0) + sq4(s1)); const float hs = rsqrtf(ss * (1.0f / 64.0f) + EPS);
            s0 = s0 * hs * p0; s1 = s1 * hs * p1; }
        *(u32x4*)(QKV + (size_t)row * NQKV + col0) = pk8(s0, s1); }
};
struct SEpiCIn { bf16_t* Z; bf16_t* XBCR; float* DT; const float* XSS; const float* dtb;
    __device__ __forceinline__ float pre(int row) const { return xss_scale(XSS, row); }
    __device__ __forceinline__ float wscale(int, int) const { return 1.0f; }
    __device__ __forceinline__ void preload(int, int, f32x4& p0, f32x4& p1) const { p0 = p1 = (f32x4){0.f, 0.f, 0.f, 0.f}; }
    __device__ __forceinline__ void apply(int row, int col0, f32x4 s0, f32x4 s1, float r, f32x4, f32x4) const {
        s0 = s0 * r; s1 = s1 * r;
        if (col0 < CDI) *(u32x4*)(Z + (size_t)row * CDI + col0) = pk8(s0, s1);
        else if (col0 < CDI + CXBC) *(u32x4*)(XBCR + (size_t)row * CXBC + col0 - CDI) = pk8(s0, s1);
        else if (col0 < CIN) { const int c = col0 - (CDI + CXBC); s0 += *(const f32x4*)(dtb + c); s1 += *(const f32x4*)(dtb + c + 4);
#pragma unroll
            for (int e = 0; e < 4; ++e) { s0[e] = s0[e] > 20.f ? s0[e] : log1pf(__expf(s0[e])); s1[e] = s1[e] > 20.f ? s1[e] : log1pf(__expf(s1[e])); }
            *(f32x4*)(DT + (size_t)row * 32 + c) = s0; *(f32x4*)(DT + (size_t)row * 32 + c + 4) = s1; } }
};
}
typedef __attribute__((address_space(1))) const float* gfp_t;
typedef __attribute__((address_space(4))) const gfp_t* tab_t;
struct Ctx {
    LAS char* lds; int tid, lane, wave, fr, fq, G, bid;
    tab_t in; float* out; unsigned char* ws;
};
__device__ __forceinline__ Ctx ctx_local(const Ctx& C0) { Ctx C = C0; int t = C0.tid; asm volatile("" : "+v"(t)); C.tid = t; C.lane = t & 63; C.wave = __builtin_amdgcn_readfirstlane(t >> 6); C.fr = C.lane & 15; C.fq = C.lane >> 4; return C; }
#define WSP(T, off) ((T*)(C.ws + (off)))
#define GASP(T, p) ((T*)(__attribute__((address_space(1))) T*)(p))
#define GIN(i) ((const float*)C.in[i])

__device__ __forceinline__ void wt_item(const float* W, int K, int N, const float* g, bf16_t* WT, LAS float* scr, int item, int lane) {
    const int nblk = N / 32, kb = item / nblk, nb = item % nblk, k0 = 64 * kb, n0 = 32 * nb;
#pragma unroll 8
    for (int i = 0; i < 32; ++i) { const int kk = 2 * i + (lane >> 5); const float s = g ? g[k0 + kk] : 1.0f; scr[kk * 33 + (lane & 31)] = W[(size_t)(k0 + kk) * N + n0 + (lane & 31)] * s; }
    LDS_WAIT(); asm volatile("" ::: "memory");
    const int c = lane & 7;
#pragma unroll
    for (int j = 0; j < 4; ++j) { const int n = (lane >> 3) + 8 * j; const LAS float* s = scr + (8 * c) * 33 + n;
        u32x4 o; o.x = pk2(s[0 * 33], s[1 * 33]); o.y = pk2(s[2 * 33], s[3 * 33]); o.z = pk2(s[4 * 33], s[5 * 33]); o.w = pk2(s[6 * 33], s[7 * 33]);
        *(u32x4*)(WT + (size_t)(n0 + n) * K + k0 + 8 * c) = o; }
    LDS_WAIT(); asm volatile("" ::: "memory");
}
__device__ __forceinline__ void wt_item64(const float* W, int K, int N, const float* g, bf16_t* WT, LAS char* scr, int item, int lane) {
    const int nblk = N / 64, kb = item / nblk, nb = item % nblk, k0 = 64 * kb, n0 = 64 * nb;
    const int krow = lane >> 4, n4 = (lane & 15) * 4;
    f32x4 v[16];
#pragma unroll
    for (int i = 0; i < 16; ++i) v[i] = *(const f32x4*)(W + (size_t)(k0 + 4 * i + krow) * N + n0 + n4);
#pragma unroll
    for (int i = 0; i < 16; ++i) { const float s = g ? g[k0 + 4 * i + krow] : 1.0f; *(LAS u32x2*)(scr + (4 * i + krow) * 144 + n4 * 2) = pk4(v[i] * s); }
    LDS_WAIT(); asm volatile("" ::: "memory");
    const int g4 = lane >> 4, i16 = lane & 15, q = i16 >> 2, p = i16 & 3;
#pragma unroll
    for (int nbk = 0; nbk < 4; ++nbk)
#pragma unroll
        for (int kh = 0; kh < 2; ++kh) { const int kk = 32 * kh + 8 * g4;
            const s16x4 lo = tr4(scr + (kk + q) * 144 + (16 * nbk + 4 * p) * 2), hi = tr4(scr + (kk + 4 + q) * 144 + (16 * nbk + 4 * p) * 2);
            u32x4 o; o.x = (unsigned)(unsigned short)lo[0] | ((unsigned)(unsigned short)lo[1] << 16); o.y = (unsigned)(unsigned short)lo[2] | ((unsigned)(unsigned short)lo[3] << 16);
            o.z = (unsigned)(unsigned short)hi[0] | ((unsigned)(unsigned short)hi[1] << 16); o.w = (unsigned)(unsigned short)hi[2] | ((unsigned)(unsigned short)hi[3] << 16);
            *(u32x4*)(WT + (size_t)(n0 + 16 * nbk + i16) * K + k0 + kk) = o; }
    LDS_WAIT(); asm volatile("" ::: "memory");
}
struct WtJob { const float* W; const float* g; bf16_t* WT; int K, N, k0, n0; };
__device__ __forceinline__ WtJob wt_decode(const Ctx& C, int it) {
    constexpr int I_UP = 16 * 64, I_DN = 64 * 16, I_AI = 16 * 96, I_AO = 48 * 16, I_QKV = 16 * 24, I_BO = 16 * 16, I_CI = 16 * 81, I_CO = 32 * 16;
    WtJob j; int r = it, nblk;
    if (r < 4 * I_UP) { const int L = r / I_UP; r -= L * I_UP; j.W = GIN(I_WUP) + (size_t)L * DM * FF; j.g = GIN(I_NMLP) + L * DM; j.WT = WSP(bf16_t, WS_WUP) + (size_t)L * FF * DM; j.K = DM; j.N = FF; }
    else if ((r -= 4 * I_UP) < 4 * I_DN) { const int L = r / I_DN; r -= L * I_DN; j.W = GIN(I_WDN) + (size_t)L * FF * DM; j.g = nullptr; j.WT = WSP(bf16_t, WS_WDN) + (size_t)L * DM * FF; j.K = FF; j.N = DM; }
    else if ((r -= 4 * I_DN) < 2 * I_AI) { const int L = r / I_AI; r -= L * I_AI; j.W = GIN(I_AWIN) + (size_t)L * DM * AFF; j.g = GIN(I_NMIX) + (L * 3) * DM; j.WT = WSP(bf16_t, WS_WAI) + (size_t)L * AFF * DM; j.K = DM; j.N = AFF; }
    else if ((r -= 2 * I_AI) < 2 * I_AO) { const int L = r / I_AO; r -= L * I_AO; j.W = GIN(I_AWOUT) + (size_t)L * AH * DM; j.g = nullptr; j.WT = WSP(bf16_t, WS_WAO) + (size_t)L * DM * AH; j.K = AH; j.N = DM; }
    else if ((r -= 2 * I_AO) < I_QKV) { j.W = GIN(I_BQKV); j.g = GIN(I_NMIX) + 1 * DM; j.WT = WSP(bf16_t, WS_WQKV); j.K = DM; j.N = NQKV; }
    else if ((r -= I_QKV) < I_BO) { j.W = GIN(I_BWO); j.g = nullptr; j.WT = WSP(bf16_t, WS_WBO); j.K = DM; j.N = DM; }
    else if ((r -= I_BO) < I_CI) { j.W = GIN(I_CWIN); j.g = GIN(I_NMIX) + 2 * DM; j.WT = WSP(bf16_t, WS_WCI); j.K = DM; j.N = CIN; }
    else { r -= I_CI; j.W = GIN(I_CWO); j.g = GIN(I_CNORM); j.WT = WSP(bf16_t, WS_WCO); j.K = CDI; j.N = DM; }
    nblk = (j.N + 63) / 64; j.k0 = 64 * (r / nblk); j.n0 = 64 * (r % nblk); return j;
}
__device__ __forceinline__ void wt_load(const WtJob& j, int lane, f32x4 (&v)[16], f32x4 (&gq)[4]) {
    const int krow = lane >> 4; int n = j.n0 + (lane & 15) * 4; n = n < j.N ? n : j.N - 4;
    const float* wp = j.W + (size_t)(j.k0 + 16 * krow) * j.N + n;
#pragma unroll
    for (int i = 0; i < 16; ++i) v[i] = ntl((const f32x4*)(wp + (size_t)i * j.N));
    const float* gp = (j.g ? j.g : j.W) + j.k0 + 16 * krow;
#pragma unroll
    for (int q = 0; q < 4; ++q) gq[q] = *(const f32x4*)(gp + 4 * q);
}
__device__ __forceinline__ void phase_prologue(const Ctx& C0) {
    const Ctx C = ctx_local(C0);
    LAS char* scr = C.lds + C.wave * 16384;
    const int gw = C.bid * 8 + C.wave, NGW = C.G * 8, lane = C.lane;
    constexpr int NIT = 4 * 16 * 64 + 4 * 64 * 16 + 2 * 16 * 96 + 2 * 48 * 16 + 16 * 24 + 16 * 16 + 16 * 81 + 32 * 16;
    {
        f32x4 v[16], gq[4]; WtJob cur;
        if (gw < NIT) { cur = wt_decode(C, gw); wt_load(cur, lane, v, gq); }
        for (int it = gw; it < NIT; it += NGW) {
            const int krow = lane >> 4, n4 = (lane & 15) * 4; const bool hasg = cur.g != nullptr, live = cur.n0 + n4 < cur.N;
#pragma unroll
            for (int i = 0; i < 16; ++i) { const float gs = hasg ? gq[i >> 2][i & 3] : 1.0f; *(LAS u32x2*)(scr + (16 * krow + i) * 144 + n4 * 2) = live ? pk4(v[i] * gs) : (u32x2){0u, 0u}; }
            const WtJob job = cur;
            if (it + NGW < NIT) { cur = wt_decode(C, it + NGW); wt_load(cur, lane, v, gq); }
            LDS_WAIT(); asm volatile("" ::: "memory");
            const int g4 = lane >> 4, i16 = lane & 15, q = i16 >> 2, p = i16 & 3;
#pragma unroll
            for (int nbk = 0; nbk < 4; ++nbk) if (job.n0 + 16 * nbk < job.N) {
#pragma unroll
                for (int kh = 0; kh < 2; ++kh) { const int kk = 32 * kh + 8 * g4;
                    const s16x4 lo = tr4(scr + (kk + q) * 144 + (16 * nbk + 4 * p) * 2), hi = tr4(scr + (kk + 4 + q) * 144 + (16 * nbk + 4 * p) * 2);
                    u32x4 o; o.x = (unsigned)(unsigned short)lo[0] | ((unsigned)(unsigned short)lo[1] << 16); o.y = (unsigned)(unsigned short)lo[2] | ((unsigned)(unsigned short)lo[3] << 16);
                    o.z = (unsigned)(unsigned short)hi[0] | ((unsigned)(unsigned short)hi[1] << 16); o.w = (unsigned)(unsigned short)hi[2] | ((unsigned)(unsigned short)hi[3] << 16);
                    *(u32x4*)(job.WT + (size_t)(job.n0 + 16 * nbk + i16) * job.K + job.k0 + kk) = o; } }
            LDS_WAIT(); asm volatile("" ::: "memory");
        }
    }
    { u32x4* z = (u32x4*)(WSP(bf16_t, WS_WCI) + (size_t)CIN * DM); const int n16 = (CINP - CIN) * DM * 2 / 16;
      u32x4 zz = (u32x4){0u, 0u, 0u, 0u}; asm volatile("" : "+v"(zz));
      for (int i = C.bid * 512 + C.tid; i < n16; i += C.G * 512) z[i] = zz; }
    bf16_t* XB = WSP(bf16_t, WS_XB); float* XSS = WSP(float, WS_XSS);
    for (int m0 = 2 * gw; m0 < MT; m0 += 2 * NGW) {
        f32x4 v[2][4];
#pragma unroll
        for (int r = 0; r < 2; ++r) { const int m = m0 + r; const float* xr = (m < MP) ? GIN(I_XP) + (size_t)m * DM : GIN(I_XS) + (size_t)(m - MP) * DM;
#pragma unroll
            for (int j = 0; j < 4; ++j) v[r][j] = ntl((const f32x4*)xr + C.lane + 64 * j); }
#pragma unroll
        for (int r = 0; r < 2; ++r) { const int m = m0 + r;
            const float ss = wave_sum((sq4(v[r][0]) + sq4(v[r][1])) + (sq4(v[r][2]) + sq4(v[r][3])));
#pragma unroll
            for (int j = 0; j < 4; ++j) *((u32x2*)(XB + (size_t)m * DM) + C.lane + 64 * j) = pk4(v[r][j]);
            if (C.lane < 16) XSS[(size_t)m * 16 + C.lane] = (C.lane == 0) ? ss : 0.f; }
    }
}

__device__ __forceinline__ void phase_spatial(const Ctx& C0, int L) {
    const Ctx C = ctx_local(C0);
    const float* wsp = GIN(I_AWSP) + (size_t)L * 8 * 128 * 128; const float* bsp = GIN(I_ABSP) + L * 8 * 128; const float* nv = GIN(I_ANV) + L * AH;
    const bf16_t* UV = WSP(bf16_t, WS_UV); bf16_t* GT = WSP(bf16_t, WS_GATED); const float* VSS = WSP(float, WS_VSS);
    LAS char* Wt = C.lds; LAS char* Vt = C.lds + 34816; LAS float* rsv = (LAS float*)(C.lds + 34816 + 102400);
    const int w = C.wave, fr = C.fr, fq = C.fq, tid = C.tid;
    const int gq = C.bid & 7; const bool gfix = (C.G & 7) == 0;
    u32x4 vreg[12];
#define SP_LOADV(uu) do { const int g_ = (uu) & 7, c_ = (uu) >> 3; _Pragma("unroll") for (int v = 0; v < 12; ++v) { const int idx = tid + 512 * v, r = idx / 48, ch = idx % 48; \
        vreg[v] = *(const u32x4*)(UV + (size_t)(128 * c_ + r) * AFF + AH + 384 * g_ + 8 * ch); } } while (0)
#define SP_STAGEW(gg) do { const int i = tid >> 2, jq = (tid & 3) * 32; _Pragma("unroll") for (int v = 0; v < 8; ++v) { const int j0 = jq + 4 * v; const f32x4 wv = *(const f32x4*)(wsp + (size_t)((gg) * 128 + i) * 128 + j0); f32x4 o; \
        _Pragma("unroll") for (int e = 0; e < 4; ++e) o[e] = (j0 + e <= i) ? wv[e] : 0.f; *(LAS u32x2*)(Wt + i * 272 + j0 * 2) = pk4(o); } } while (0)
    LAS float* nvL = (LAS float*)(C.lds + 34816 + 102400 + 512);
#define SP_STAGENV(gg) do { if (tid < 96) *(LAS f32x4*)(nvL + 4 * tid) = *(const f32x4*)(nv + 384 * (gg) + 4 * tid); } while (0)
    if (gfix) { SP_STAGEW(gq); SP_STAGENV(gq); }
    float bias = gfix ? bsp[gq * 128 + 16 * w + fr] : 0.f;
    if (C.bid < 1024) SP_LOADV(C.bid);
    for (int u = C.bid; u < 1024; u += C.G) {
        const int g = u & 7, c = u >> 3;
        if (tid < 128) { const f32x4* p = (const f32x4*)(VSS + (size_t)(128 * c + tid) * 48); float s = 0.f;
#pragma unroll
            for (int k = 0; k < 12; ++k) { const f32x4 t = p[k]; s += (t[0] + t[1]) + (t[2] + t[3]); }
            rsv[tid] = rsqrtf(s * (1.0f / 3072.0f) + EPS); }
        if (!gfix) { SP_STAGEW(g); SP_STAGENV(g); bias = bsp[g * 128 + 16 * w + fr]; }
#pragma unroll
        for (int v = 0; v < 12; ++v) { const int idx = tid + 512 * v, r = idx / 48, ch = idx % 48, t = ch >> 2, a = ch & 3;
            *(LAS u32x2*)(Vt + r * 800 + (32 * t + 4 * a) * 2) = (u32x2){vreg[v].x, vreg[v].y}; *(LAS u32x2*)(Vt + r * 800 + (32 * t + 16 + 4 * a) * 2) = (u32x2){vreg[v].z, vreg[v].w}; }
        if (u + C.G < 1024) SP_LOADV(u + C.G);
        const int i = 16 * w + fr; const size_t row = (size_t)128 * c + i;
        __syncthreads();
#pragma unroll 1
        for (int hf = 0; hf < 2; ++hf) {
            u32x4 uu[6];
#pragma unroll
            for (int t = 0; t < 6; ++t) uu[t] = *(const u32x4*)(UV + row * AFF + 384 * g + 192 * hf + 32 * t + 8 * fq);
            f32x4 acc[12];
#pragma unroll
            for (int nb = 0; nb < 12; ++nb) acc[nb] = (f32x4){0.f, 0.f, 0.f, 0.f};
            LAS const char* vlb = Vt + (8 * fq) * 800 + TR_LANE_OFF(C.lane, 800);
#pragma unroll
            for (int kk = 0; kk < 4; ++kk) if (32 * kk <= 16 * w + 15) {
                const u32x4 bwr = *(const LAS u32x4*)(Wt + (16 * w + fr) * 272 + (32 * kk + 8 * fq) * 2);
                const f32x4 r0 = *(const LAS f32x4*)(rsv + 32 * kk + 8 * fq), r1 = *(const LAS f32x4*)(rsv + 32 * kk + 8 * fq + 4);
                const bf16x8 bw = __builtin_bit_cast(bf16x8, pk8(unpk4((u32x2){bwr.x, bwr.y}) * r0, unpk4((u32x2){bwr.z, bwr.w}) * r1));
#pragma unroll
                for (int nb = 0; nb < 12; ++nb) { const bf16x8 av = tr_frag_b(vlb + (32 * kk) * 800 + 384 * hf, 4 * 800, 16 * nb); acc[nb] = MFMA16(av, bw, acc[nb]); } }
#pragma unroll
            for (int t = 0; t < 6; ++t) { const int col = 384 * g + 192 * hf + 32 * t + 8 * fq; const f32x4 n0 = *(const LAS f32x4*)(nvL + 192 * hf + 32 * t + 8 * fq), n1 = *(const LAS f32x4*)(nvL + 192 * hf + 32 * t + 8 * fq + 4);
                const f32x4 u0 = unpk4((u32x2){uu[t].x, uu[t].y}), u1 = unpk4((u32x2){uu[t].z, uu[t].w});
                *(u32x4*)(GT + row * AH + col) = pk8(u0 * (acc[2 * t] * n0 + bias), u1 * (acc[2 * t + 1] * n1 + bias)); }
        }
        __syncthreads();
    }
#undef SP_LOADV
#undef SP_STAGEW
#undef SP_STAGENV
    float* ocv = C.out + O_CV + (size_t)L * 128 * 4 * AH;
    for (int su = C.bid; su < 256; su += C.G) { const int s = su >> 1, chalf = su & 1;
        if (tid < 4) { const f32x4* p = (const f32x4*)(VSS + (size_t)(MP + 4 * s + tid) * 48); float sm = 0.f;
#pragma unroll
            for (int k = 0; k < 12; ++k) { const f32x4 t = p[k]; sm += (t[0] + t[1]) + (t[2] + t[3]); }
            rsv[tid] = rsqrtf(sm * (1.0f / 3072.0f) + EPS); }
        __syncthreads();
        for (int cg = 384 * chalf + tid; cg < 384 * chalf + 384; cg += 512) { const int col = 4 * cg, g = col / 384;
            const f32x4 nvv = *(const f32x4*)(nv + col);
            u32x2 vr[4], ur[4]; float wv[10], bv[4];
#pragma unroll
            for (int t = 0; t < 4; ++t) { const size_t row = (size_t)MP + 4 * s + t; vr[t] = *(const u32x2*)(UV + row * AFF + AH + col); ur[t] = *(const u32x2*)(UV + row * AFF + col); }
#pragma unroll
            for (int i = 0; i < 4; ++i) { bv[i] = bsp[g * 128 + i];
#pragma unroll
                for (int j = 0; j <= i; ++j) wv[i * (i + 1) / 2 + j] = wsp[(size_t)(g * 128 + i) * 128 + j]; }
            f32x4 vn[4];
#pragma unroll
            for (int t = 0; t < 4; ++t) vn[t] = unpk4(vr[t]) * rsv[t] * nvv;
            u32x2 og[4];
#pragma unroll
            for (int i = 0; i < 4; ++i) { f32x4 sv = (f32x4){0.f, 0.f, 0.f, 0.f};
#pragma unroll
                for (int j = 0; j <= i; ++j) sv += vn[j] * wv[i * (i + 1) / 2 + j];
                sv += bv[i]; og[i] = pk4(unpk4(ur[i]) * sv); }
#pragma unroll
            for (int t = 0; t < 4; ++t) { nts(vn[t], (f32x4*)(ocv + ((size_t)s * 4 + t) * AH + col)); *(u32x2*)(GT + ((size_t)MP + 4 * s + t) * AH + col) = og[t]; } }
        __syncthreads();
    }
}

__device__ __forceinline__ int t5_bucket(int rel) {
    if (rel < 16) return rel;
    int lg = 16 + (int)(__logf((float)rel / 16.0f) / 2.0794415416798357f * 16.0f); return lg < 31 ? lg : 31;
}
__device__ __forceinline__ void phase_attn(const Ctx& C0) {
    const Ctx C = ctx_local(C0);
    const bf16_t* QKV = WSP(bf16_t, WS_QKV); bf16_t* O = WSP(bf16_t, WS_O);
    const float* relb = GIN(I_RELB); const float* sinks = GIN(I_BSINK);
    const int w = C.wave, fr = C.fr, fq = C.fq, tid = C.tid, lane = C.lane;
    {
        LAS char* Kt = C.lds; LAS char* Vt = C.lds + 36864; LAS float* bt = (LAS float*)(C.lds + 73728);
        u32x4 kreg[4], vreg[4];
#define ATT_LOADKV(uu) do { const int qb_ = (uu) & 31, kh_ = ((uu) >> 5) & 3, b_ = (uu) >> 7; _Pragma("unroll") for (int v = 0; v < 4; ++v) { const int idx = tid + 512 * v, r = idx >> 3, ch = idx & 7; const int pos = 128 * (qb_ - 1) + r; \
            kreg[v] = (u32x4){0u, 0u, 0u, 0u}; vreg[v] = kreg[v]; \
            if (pos >= 0) { const size_t row = (size_t)b_ * 4096 + pos; kreg[v] = *(const u32x4*)(QKV + row * NQKV + 1024 + 64 * kh_ + 8 * ch); vreg[v] = *(const u32x4*)(QKV + row * NQKV + 1280 + 64 * kh_ + 8 * ch); } } } while (0)
#ifdef ATT_REP_PROMPT
        for (int rep_ = 0; rep_ < 2; ++rep_) {
#endif
        for (int e = tid; e < 2048; e += 512) bt[e] = relb[t5_bucket(e & 127) * 16 + (e >> 7)];
        const int vb = ((C.G & 7) == 0) ? (C.bid & 7) * (C.G >> 3) + (C.bid >> 3) : C.bid;
        if (vb < 512) ATT_LOADKV(vb);
        for (int u = vb; u < 512; u += C.G) {
            const int qb = u & 31, kh = (u >> 5) & 3, b = u >> 7;
#pragma unroll
            for (int v = 0; v < 4; ++v) { const int idx = tid + 512 * v, r = idx >> 3, ch = idx & 7;
                *(LAS u32x4*)(Kt + r * 144 + ch * 16) = kreg[v]; *(LAS u32x4*)(Vt + r * 144 + ch * 16) = vreg[v]; }
            __syncthreads();
            if (qb == 31) {
                float* okp = C.out + O_KP; float* ovp = C.out + O_VP;
                for (int idx = tid; idx < 1024; idx += 512) { const int r = idx >> 3, ch = idx & 7;
                    const u32x4 kv = *(const LAS u32x4*)(Kt + (128 + r) * 144 + ch * 16), vv = *(const LAS u32x4*)(Vt + (128 + r) * 144 + ch * 16);
                    const size_t o = (((size_t)b * 128 + r) * 4 + kh) * 64 + 8 * ch;
                    *(f32x4*)(okp + o) = unpk4((u32x2){kv.x, kv.y}); *(f32x4*)(okp + o + 4) = unpk4((u32x2){kv.z, kv.w});
                    *(f32x4*)(ovp + o) = unpk4((u32x2){vv.x, vv.y}); *(f32x4*)(ovp + o + 4) = unpk4((u32x2){vv.z, vv.w}); }
            }
            const int rh = w >> 1, head = 4 * kh + rh; const float sink = sinks[head]; const LAS float* bth = bt + head * 128;
            bf16x8 qn[2];
#pragma unroll
            for (int kk = 0; kk < 2; ++kk) qn[kk] = *(const bf16x8*)(QKV + ((size_t)b * 4096 + 128 * qb + (w & 1) * 64 + fr) * NQKV + 64 * head + 32 * kk + 8 * fq);
            if (u + C.G < 512) ATT_LOADKV(u + C.G);
#pragma unroll 1
            for (int it = 0; it < 4; ++it) {
                const int qi0 = ((w & 1) * 4 + it) * 16, qi = qi0 + fr; const size_t qrow = (size_t)b * 4096 + 128 * qb + qi;
                bf16x8 qf[2];
#pragma unroll
                for (int kk = 0; kk < 2; ++kk) { qf[kk] = qn[kk]; if (it < 3) qn[kk] = *(const bf16x8*)(QKV + (qrow + 16) * NQKV + 64 * head + 32 * kk + 8 * fq); }
                const int nbs = (qi0 >> 4) & ~1;
                f32x4 sa[10];
#pragma unroll
                for (int jb = 0; jb < 10; ++jb) { sa[jb] = (f32x4){0.f, 0.f, 0.f, 0.f};
#pragma unroll
                    for (int kk = 0; kk < 2; ++kk) { const bf16x8 kf = *(const LAS bf16x8*)(Kt + (16 * (nbs + jb) + fr) * 144 + (32 * kk + 8 * fq) * 2); sa[jb] = MFMA16(kf, qf[kk], sa[jb]); } }
                float mx = sink;
#pragma unroll
                for (int jb = 0; jb < 10; ++jb)
#pragma unroll
                    for (int e = 0; e < 4; ++e) { const int kj = 16 * (nbs + jb) + 4 * fq + e, rel = 128 + qi - kj; const bool valid = (rel >= 0) && (rel < 128) && (qb > 0 || kj >= 128);
                        const int rc = rel < 0 ? 0 : (rel > 127 ? 127 : rel);
                        const float l = valid ? sa[jb][e] * 0.125f + bth[rc] : -1e30f; sa[jb][e] = l; mx = fmaxf(mx, l); }
                mx = fmaxf(mx, __shfl_xor(mx, 16)); mx = fmaxf(mx, __shfl_xor(mx, 32));
                float sum = 0.f;
#pragma unroll
                for (int jb = 0; jb < 10; ++jb)
#pragma unroll
                    for (int e = 0; e < 4; ++e) { const float p = __expf(sa[jb][e] - mx); sa[jb][e] = p; sum += p; }
                sum += __shfl_xor(sum, 16); sum += __shfl_xor(sum, 32);
                const float inv = 1.0f / (sum + __expf(sink - mx));
                f32x4 oa[4];
#pragma unroll
                for (int db = 0; db < 4; ++db) oa[db] = (f32x4){0.f, 0.f, 0.f, 0.f};
                LAS const char* vlb = Vt + (4 * fq) * 144 + TR_LANE_OFF(lane, 144);
#pragma unroll
                for (int s5 = 0; s5 < 5; ++s5) { const u32x4 pw = pk8(sa[2 * s5], sa[2 * s5 + 1]); const bf16x8 pf = __builtin_bit_cast(bf16x8, pw); const int k0 = 16 * nbs + 32 * s5;
#pragma unroll
                    for (int db = 0; db < 4; ++db) { const bf16x8 vf = tr_frag_b(vlb + (16 * nbs + 32 * s5) * 144, 16 * 144, 16 * db); oa[db] = MFMA16(vf, pf, oa[db]); } }
#pragma unroll
                for (int db = 0; db < 4; ++db) *(u32x2*)(O + qrow * DM + 64 * head + 16 * db + 4 * fq) = pk4(oa[db] * inv);
            }
            __syncthreads();
        }
#ifdef ATT_REP_PROMPT
        }
#endif
    }
#undef ATT_LOADKV
    {
        LAS float* btS = (LAS float*)C.lds;
        LAS char* Vw = C.lds + 8192 + w * 24576;
        const float* ck = GIN(I_CK); const float* cv = GIN(I_CV); float* oks = C.out + O_KS; float* ovs = C.out + O_VS;
        for (int e = tid; e < 2048; e += 512) btS[e] = relb[t5_bucket(e & 127) * 16 + (e >> 7)];
        __syncthreads();
        for (int uw = 0; uw < 6; ++uw) { const int u = uw * C.G + C.bid; if (u >= 512) break;
            const int s = u >> 2, kh = u & 3; const size_t cbase = ((size_t)s * 128 * 4 + kh) * 64; const bf16_t* nrow = QKV + ((size_t)MP + 4 * s) * NQKV; LAS char* Vu = C.lds + 8192 + uw * 24576;
#pragma unroll
            for (int k = 0; k < 2; ++k) { const int e = tid + 512 * k, idx = e >> 3, ch = e & 7; const float* p = cv + cbase + (size_t)idx * 256 + 8 * ch;
                *(LAS u32x4*)(Vu + idx * 144 + ch * 16) = pk8(ntl((const f32x4*)p), ntl((const f32x4*)(p + 4))); }
            if (tid < 256) { const int idx = 128 + (tid >> 3), ch = tid & 7; u32x4 v = (u32x4){0u, 0u, 0u, 0u};
                if (idx < 132) v = *(const u32x4*)(nrow + (size_t)(idx - 128) * NQKV + 1280 + 64 * kh + 8 * ch);
                *(LAS u32x4*)(Vu + idx * 144 + ch * 16) = v; }
#pragma unroll
            for (int k = 0; k < 4; ++k) { int e = tid + 512 * k; e = e < 1984 ? e : 1983; const int j = e >> 4, c4 = (e & 15) * 4; const size_t o = cbase + (size_t)j * 256 + c4;
                const f32x4 kv = ntl((const f32x4*)(ck + o + 4 * 256)), vv = ntl((const f32x4*)(cv + o + 4 * 256)); nts(kv, (f32x4*)(oks + o)); nts(vv, (f32x4*)(ovs + o)); }
            if (tid < 64) { const int j = 124 + (tid >> 4), c4 = (tid & 15) * 4; const size_t o = cbase + (size_t)j * 256 + c4;
                const f32x4 kv = unpk4(*(const u32x2*)(nrow + (size_t)(j - 124) * NQKV + 1024 + 64 * kh + c4)), vv = unpk4(*(const u32x2*)(nrow + (size_t)(j - 124) * NQKV + 1280 + 64 * kh + c4));
                nts(kv, (f32x4*)(oks + o)); nts(vv, (f32x4*)(ovs + o)); }
        }
        __syncthreads();
        for (int u = w * C.G + C.bid; u < 512 && w < 6; u += 6 * C.G) {
            const int s = u >> 2, kh = u & 3; const size_t cbase = ((size_t)s * 128 * 4 + kh) * 64;
            const bf16_t* nrow = QKV + ((size_t)MP + 4 * s) * NQKV;
            const int r = fr >> 2, t = fr & 3, head = 4 * kh + r; const size_t qrow = (size_t)MP + 4 * s + t;
            bf16x8 qf[2]; const float sink = sinks[head];
#pragma unroll
            for (int kk = 0; kk < 2; ++kk) qf[kk] = *(const bf16x8*)(QKV + qrow * NQKV + 64 * head + 32 * kk + 8 * fq);
            f32x4 sa[9];
            { u32x4 kn[2];
#pragma unroll
              for (int kk = 0; kk < 2; ++kk) { kn[kk] = (u32x4){0u, 0u, 0u, 0u}; if (fr < 4) kn[kk] = *(const u32x4*)(nrow + (size_t)fr * NQKV + 1024 + 64 * kh + 32 * kk + 8 * fq); }
              sa[8] = (f32x4){0.f, 0.f, 0.f, 0.f};
#pragma unroll
              for (int kk = 0; kk < 2; ++kk) sa[8] = MFMA16(__builtin_bit_cast(bf16x8, kn[kk]), qf[kk], sa[8]); }
#pragma unroll
            for (int nb0 = 0; nb0 < 8; nb0 += 4) { f32x4 kl[4][2][2];
#pragma unroll
                for (int nb = 0; nb < 4; ++nb)
#pragma unroll
                    for (int kk = 0; kk < 2; ++kk) { const float* p = ck + cbase + (size_t)(16 * (nb0 + nb) + fr) * 256 + 32 * kk + 8 * fq; kl[nb][kk][0] = ntl((const f32x4*)p); kl[nb][kk][1] = ntl((const f32x4*)(p + 4)); }
#pragma unroll
                for (int nb = 0; nb < 4; ++nb) { sa[nb0 + nb] = (f32x4){0.f, 0.f, 0.f, 0.f};
#pragma unroll
                    for (int kk = 0; kk < 2; ++kk) sa[nb0 + nb] = MFMA16(__builtin_bit_cast(bf16x8, pk8(kl[nb][kk][0], kl[nb][kk][1])), qf[kk], sa[nb0 + nb]); } }
            float mx = sink;
#pragma unroll
            for (int nb = 0; nb < 9; ++nb)
#pragma unroll
                for (int e = 0; e < 4; ++e) { const int idx = 16 * nb + 4 * fq + e, rel = t + 128 - idx; const bool valid = (rel >= 0) && (rel < 128);
                    const float l = valid ? sa[nb][e] * 0.125f + btS[head * 128 + (valid ? rel : 0)] : -1e30f; sa[nb][e] = l; mx = fmaxf(mx, l); }
            mx = fmaxf(mx, __shfl_xor(mx, 16)); mx = fmaxf(mx, __shfl_xor(mx, 32));
            float sum = 0.f;
#pragma unroll
            for (int nb = 0; nb < 9; ++nb)
#pragma unroll
                for (int e = 0; e < 4; ++e) { const float p = __expf(sa[nb][e] - mx); sa[nb][e] = p; sum += p; }
            sum += __shfl_xor(sum, 16); sum += __shfl_xor(sum, 32);
            const float inv = 1.0f / (sum + __expf(sink - mx));
            f32x4 oa[4];
#pragma unroll
            for (int db = 0; db < 4; ++db) oa[db] = (f32x4){0.f, 0.f, 0.f, 0.f};
            LAS const char* vlb = Vw + (4 * fq) * 144 + TR_LANE_OFF(lane, 144);
#pragma unroll
            for (int s5 = 0; s5 < 5; ++s5) { const u32x4 pw = pk8(sa[2 * s5], s5 < 4 ? sa[2 * s5 + 1] : (f32x4){0.f, 0.f, 0.f, 0.f}); const bf16x8 pf = __builtin_bit_cast(bf16x8, pw);
#pragma unroll
                for (int db = 0; db < 4; ++db) { const bf16x8 vf = tr_frag_b(vlb + (32 * s5) * 144, 16 * 144, 16 * db); oa[db] = MFMA16(vf, pf, oa[db]); } }
#pragma unroll
            for (int db = 0; db < 4; ++db) *(u32x2*)(O + qrow * DM + 64 * head + 16 * db + 4 * fq) = pk4(oa[db] * inv);
        }
        __syncthreads();
    }
}
template <int NCH> __device__ __forceinline__ void stage_conv(const bf16_t* XR, const float* cw, const float* cb, size_t row0, int pos0, int col0, LAS char* dst, int pitch, int tstride, const LAS float* sc, int tid) {
    constexpr int RG = NCH * 128 / 512;
    const int ch = tid % NCH, r0 = (tid / NCH) * RG, col = col0 + 8 * ch;
    f32x4 w0[4], w1[4];
#pragma unroll
    for (int tap = 0; tap < 4; ++tap) { w0[tap] = *(const f32x4*)(cw + tap * CXBC + col); w1[tap] = *(const f32x4*)(cw + tap * CXBC + col + 4); }
    const f32x4 b0 = *(const f32x4*)(cb + col), b1 = *(const f32x4*)(cb + col + 4);
    u32x4 raw[RG + 3];
#pragma unroll
    for (int k = 0; k < RG + 3; ++k) { raw[k] = (u32x4){0u, 0u, 0u, 0u}; if (pos0 + r0 - 3 + k >= 0) raw[k] = *(const u32x4*)(XR + (row0 + r0 - 3 + k) * CXBC + col); }
    LAS char* d = dst + (ch >> 3) * tstride + (ch & 7) * 16;
#pragma unroll
    for (int q = 0; q < RG; ++q) { f32x4 a0 = b0, a1 = b1;
#pragma unroll
        for (int tap = 0; tap < 4; ++tap) { const u32x4 x = raw[q + tap]; a0 += unpk4((u32x2){x.x, x.y}) * w0[tap]; a1 += unpk4((u32x2){x.z, x.w}) * w1[tap]; }
#pragma unroll
        for (int e = 0; e < 4; ++e) { a0[e] = silu_f(a0[e]); a1[e] = silu_f(a1[e]); }
        if (sc) { const float s = sc[(ch >> 3) * 128 + r0 + q]; a0 = a0 * s; a1 = a1 * s; }
        *(LAS u32x4*)(d + (r0 + q) * pitch) = pk8(a0, a1); }
}
template <int NCH> __device__ __forceinline__ void stage_load(const bf16_t* XR, size_t row0, int pos0, int col0, int tid, u32x4 (&raw)[NCH * 128 / 512 + 3]) {
    constexpr int RG = NCH * 128 / 512;
    const int ch = tid % NCH, r0 = (tid / NCH) * RG, col = col0 + 8 * ch;
#pragma unroll
    for (int k = 0; k < RG + 3; ++k) { const int rr = r0 - 3 + k; const size_t row = (pos0 + rr >= 0) ? row0 + rr : row0; raw[k] = *(const u32x4*)(XR + row * CXBC + col); }
}
template <int NCH> __device__ __forceinline__ void stage_fin(u32x4 (&raw)[NCH * 128 / 512 + 3], const float* cw, const float* cb, int pos0, int col0, LAS char* dst, int pitch, int tstride, int tid) {
    constexpr int RG = NCH * 128 / 512;
    const int ch = tid % NCH, r0 = (tid / NCH) * RG, col = col0 + 8 * ch;
    f32x4 w0[4], w1[4];
#pragma unroll
    for (int tap = 0; tap < 4; ++tap) { w0[tap] = *(const f32x4*)(cw + tap * CXBC + col); w1[tap] = *(const f32x4*)(cw + tap * CXBC + col + 4); }
    const f32x4 b0 = *(const f32x4*)(cb + col), b1 = *(const f32x4*)(cb + col + 4);
#pragma unroll
    for (int k = 0; k < 3; ++k) if (pos0 + r0 - 3 + k < 0) raw[k] = (u32x4){0u, 0u, 0u, 0u};
    LAS char* d = dst + (ch >> 3) * tstride + (ch & 7) * 16;
#pragma unroll
    for (int q = 0; q < RG; ++q) { f32x4 a0 = b0, a1 = b1;
#pragma unroll
        for (int tap = 0; tap < 4; ++tap) { const u32x4 x = raw[q + tap]; a0 += unpk4((u32x2){x.x, x.y}) * w0[tap]; a1 += unpk4((u32x2){x.z, x.w}) * w1[tap]; }
#pragma unroll
        for (int e = 0; e < 4; ++e) { a0[e] = silu_f(a0[e]); a1[e] = silu_f(a1[e]); }
        *(LAS u32x4*)(d + (r0 + q) * pitch) = pk8(a0, a1); }
}
__device__ __forceinline__ void conv_small(const Ctx& C) {
    const bf16_t* XR = WSP(bf16_t, WS_XBCR); bf16_t* XCS = WSP(bf16_t, WS_XBCC);
    const float* cw = GIN(I_CCW); const float* cb = GIN(I_CCB); const float* sc = GIN(I_CONV);
    float* ocp = C.out + O_CONVP; float* ocs = C.out + O_CONVS;
    for (int it = C.bid * 512 + C.tid; it < MS * 384; it += C.G * 512) {
        const int srow = it / 384, col = (it % 384) * 8;
        f32x4 a0 = *(const f32x4*)(cb + col), a1 = *(const f32x4*)(cb + col + 4);
        const int s = srow >> 2, t = srow & 3;
#pragma unroll
        for (int tap = 0; tap < 4; ++tap) { const int xi = t + tap; f32x4 x0, x1;
            if (xi < 3) { const float* p = sc + ((size_t)s * 3 + xi) * CXBC + col; x0 = *(const f32x4*)p; x1 = *(const f32x4*)(p + 4); }
            else { const u32x4 x = *(const u32x4*)(XR + (size_t)(MP + 4 * s + xi - 3) * CXBC + col); x0 = unpk4((u32x2){x.x, x.y}); x1 = unpk4((u32x2){x.z, x.w}); }
            a0 += x0 * *(const f32x4*)(cw + tap * CXBC + col); a1 += x1 * *(const f32x4*)(cw + tap * CXBC + col + 4);
            if (tap == 3 && t >= 1) { float* o = ocs + ((size_t)s * 3 + (t - 1)) * CXBC + col; *(f32x4*)o = x0; *(f32x4*)(o + 4) = x1; } }
#pragma unroll
        for (int e = 0; e < 4; ++e) { a0[e] = silu_f(a0[e]); a1[e] = silu_f(a1[e]); }
        *(u32x4*)(XCS + (size_t)srow * CXBC + col) = pk8(a0, a1);
    }
    for (int it = C.bid * 512 + C.tid; it < 4 * 3 * 384; it += C.G * 512) { const int col = (it % 384) * 8, k = (it / 384) % 3, b = it / (3 * 384);
        const u32x4 x = *(const u32x4*)(XR + ((size_t)b * 4096 + 4093 + k) * CXBC + col); float* o = ocp + ((size_t)b * 3 + k) * CXBC + col;
        *(f32x4*)o = unpk4((u32x2){x.x, x.y}); *(f32x4*)(o + 4) = unpk4((u32x2){x.z, x.w}); }
}

__device__ __forceinline__ void phase_states(const Ctx& C0) {
    const Ctx C = ctx_local(C0);
    const bf16_t* XR = WSP(bf16_t, WS_XBCR); const float* cw = GIN(I_CCW); const float* cb = GIN(I_CCB); const float* DT = WSP(float, WS_DT); float* ACS = WSP(float, WS_ACS); float* CDEC = WSP(float, WS_CDEC);
    bf16_t* ST = WSP(bf16_t, WS_STATES); bf16_t* YI = WSP(bf16_t, WS_YG); bf16_t* CSV = WSP(bf16_t, WS_CSAVE); const float* Dsk = GIN(I_CD);
    conv_small(C);
    LAS char* Bt = C.lds; LAS char* cbL = C.lds + 34816; LAS char* XB = C.lds + 69632;
    LAS float* acsL = (LAS float*)(C.lds + 143360); LAS float* dtL = (LAS float*)(C.lds + 147456); LAS float* scL = (LAS float*)(C.lds + 151552);
    const int w = C.wave, fr = C.fr, fq = C.fq, tid = C.tid, lane = C.lane;
    for (int u = C.bid; u < 512; u += C.G) {
        const int g = u & 3, c = (u >> 2) & 31, b = u >> 7; const size_t row0 = (size_t)b * 4096 + 128 * c;
        {
            const int h = 8 * g + w; const float A = -__expf(GIN(I_CALOG)[h]);
            const int t0 = 2 * lane; const float d0 = DT[(row0 + t0) * 32 + h], d1 = DT[(row0 + t0 + 1) * 32 + h];
            const float a0 = d0 * A, a1 = d1 * A; float s = a0 + a1;
#pragma unroll
            for (int off = 1; off < 64; off <<= 1) { const float v = __shfl_up(s, off); if (lane >= off) s += v; }
            const float acs1 = s, acs0 = s - a1; const float tot = __shfl(s, 63);
            ACS[(row0 + t0) * 32 + h] = acs0; ACS[(row0 + t0 + 1) * 32 + h] = acs1;
            acsL[w * 128 + t0] = acs0; acsL[w * 128 + t0 + 1] = acs1; dtL[w * 128 + t0] = d0; dtL[w * 128 + t0 + 1] = d1;
            scL[w * 128 + t0] = __expf(tot - acs0) * d0; scL[w * 128 + t0 + 1] = __expf(tot - acs1) * d1;
            if (lane == 63) CDEC[((size_t)b * 32 + c) * 32 + h] = __expf(tot);
        }
        stage_conv<16>(XR, cw, cb, row0, 128 * c, 2048 + 128 * g, Bt, 272, 128, nullptr, tid);
        stage_conv<16>(XR, cw, cb, row0, 128 * c, 2560 + 128 * g, XB, 272, 128, nullptr, tid);
        u32x4 rawX[11];
        stage_load<32>(XR, row0, 128 * c, 64 * (8 * g), tid, rawX);
        __syncthreads();
        {
            bf16_t* cs = CSV + (((size_t)b * 32 + c) * 4 + g) * 16384;
#pragma unroll
            for (int v = 0; v < 4; ++v) { const int idx = tid + 512 * v, r = idx >> 4, ch = idx & 15; *(u32x4*)(cs + r * 128 + 8 * ch) = *(const LAS u32x4*)(XB + r * 272 + ch * 16); } }
#pragma unroll
        for (int jb = 0; jb < 8; ++jb) { f32x4 a = (f32x4){0.f, 0.f, 0.f, 0.f};
            if (jb <= w) {
#pragma unroll
                for (int kk = 0; kk < 4; ++kk) { const bf16x8 af = *(const LAS bf16x8*)(Bt + (16 * jb + fr) * 272 + (32 * kk + 8 * fq) * 2);
                    const bf16x8 bf = *(const LAS bf16x8*)(XB + (16 * w + fr) * 272 + (32 * kk + 8 * fq) * 2); a = MFMA16(af, bf, a); } }
            *(LAS u32x2*)(cbL + (16 * w + fr) * 272 + (16 * jb + 4 * fq) * 2) = pk4(a); }
        __syncthreads();
#pragma unroll
        for (int rd = 0; rd < 2; ++rd) {
            stage_fin<32>(rawX, cw, cb, 128 * c, 64 * (8 * g + 4 * rd), XB, 144, 18432, tid);
            if (rd == 0) stage_load<32>(XR, row0, 128 * c, 64 * (8 * g + 4), tid, rawX);
            __syncthreads();
            const int hl = w >> 1, half = w & 1, hidx = 4 * rd + hl, head = 8 * g + hidx; LAS const char* Xh = XB + hl * 18432;
            {
                f32x4 acc[4][4];
#pragma unroll
                for (int nb = 0; nb < 4; ++nb)
#pragma unroll
                    for (int pb = 0; pb < 4; ++pb) acc[nb][pb] = (f32x4){0.f, 0.f, 0.f, 0.f};
#pragma unroll
                for (int kk = 0; kk < 4; ++kk) { bf16x8 xf[4];
                    const f32x4 s0 = *(const LAS f32x4*)(scL + hidx * 128 + 32 * kk + 8 * fq), s1 = *(const LAS f32x4*)(scL + hidx * 128 + 32 * kk + 8 * fq + 4);
#pragma unroll
                    for (int pb = 0; pb < 4; ++pb) { const u32x4 xr = __builtin_bit_cast(u32x4, tr_frag_b(Xh + (32 * kk + 8 * fq) * 144 + TR_LANE_OFF(lane, 144), 4 * 144, 16 * pb));
                        xf[pb] = __builtin_bit_cast(bf16x8, pk8(unpk4((u32x2){xr.x, xr.y}) * s0, unpk4((u32x2){xr.z, xr.w}) * s1)); }
#pragma unroll
                    for (int nb = 0; nb < 4; ++nb) { const bf16x8 af = tr_frag_b(Bt + (32 * kk + 8 * fq) * 272 + TR_LANE_OFF(lane, 272) + 128 * half, 4 * 272, 16 * nb);
#pragma unroll
                        for (int pb = 0; pb < 4; ++pb) acc[nb][pb] = MFMA16(af, xf[pb], acc[nb][pb]); } }
                bf16_t* su = ST + (((size_t)b * 32 + c) * 32 + head) * 8192;
#pragma unroll
                for (int nb = 0; nb < 4; ++nb)
#pragma unroll
                    for (int pb = 0; pb < 4; ++pb) { const int nbp = 4 * half + nb;
                        *(u32x2*)(su + ((((pb * 4 + (nbp >> 1)) * 4 + 2 * (nbp & 1) + (fq >> 1)) * 16 + fr) * 8 + 4 * (fq & 1))) = pk4(acc[nb][pb]); }
            }
            {
                const float dsk = Dsk[head];
#pragma unroll 1
                for (int ibl = 0; ibl < 4; ++ibl) {
                    const int ib = 4 * half + ibl, i = 16 * ib + fr; const float ai = acsL[hidx * 128 + i];
                    f32x4 a1[4];
#pragma unroll
                    for (int pb = 0; pb < 4; ++pb) a1[pb] = (f32x4){0.f, 0.f, 0.f, 0.f};
                    const int nk = ((16 * ib + 15) >> 5) + 1;
                    for (int kk = 0; kk < nk; ++kk) { const int j0 = 32 * kk + 8 * fq;
                        const u32x4 cbv = *(const LAS u32x4*)(cbL + i * 272 + j0 * 2);
                        const f32x4 c0 = unpk4((u32x2){cbv.x, cbv.y}), c1 = unpk4((u32x2){cbv.z, cbv.w});
                        const f32x4 aj0 = *(const LAS f32x4*)(acsL + hidx * 128 + j0), aj1 = *(const LAS f32x4*)(acsL + hidx * 128 + j0 + 4);
                        const f32x4 dj0 = *(const LAS f32x4*)(dtL + hidx * 128 + j0), dj1 = *(const LAS f32x4*)(dtL + hidx * 128 + j0 + 4);
                        f32x4 w0, w1;
#pragma unroll
                        for (int e = 0; e < 4; ++e) { w0[e] = (j0 + e <= i) ? c0[e] * __expf(ai - aj0[e]) * dj0[e] : 0.f; w1[e] = (j0 + 4 + e <= i) ? c1[e] * __expf(ai - aj1[e]) * dj1[e] : 0.f; }
                        const bf16x8 wf = __builtin_bit_cast(bf16x8, pk8(w0, w1));
#pragma unroll
                        for (int pb = 0; pb < 4; ++pb) { const bf16x8 xf = tr_frag_b(Xh + j0 * 144 + TR_LANE_OFF(lane, 144), 4 * 144, 16 * pb); a1[pb] = MFMA16(xf, wf, a1[pb]); } }
#pragma unroll
                    for (int pb = 0; pb < 4; ++pb) { const f32x4 xv = unpk4(*(const LAS u32x2*)(Xh + i * 144 + (16 * pb + 4 * fq) * 2));
                        *(u32x2*)(YI + (row0 + i) * CDI + 64 * head + 16 * pb + 4 * fq) = pk4(a1[pb] + xv * dsk); }
                }
            }
            __syncthreads();
        }
    }
}

__device__ __forceinline__ void phase_scan(const Ctx& C0) {
    const Ctx C = ctx_local(C0);
    const bf16_t* ST = WSP(bf16_t, WS_STATES); bf16_t* HP = WSP(bf16_t, WS_HPREV); const float* CDEC = WSP(float, WS_CDEC); float* osp = C.out + O_SSMP;
    for (int idx = C.bid * 512 + C.tid; idx < 131072; idx += C.G * 512) {
        const int cq = idx & 1023, bh = idx >> 10, b = bh >> 5, h = bh & 31;
        const int p = 16 * (cq >> 8) + (cq & 15), n0 = 32 * ((cq >> 6) & 3) + 8 * ((cq >> 4) & 3);
        f32x4 h0 = (f32x4){0.f, 0.f, 0.f, 0.f}, h1 = h0;
#pragma unroll 1
        for (int c8 = 0; c8 < 32; c8 += 8) { u32x4 st[8]; float dec[8];
#pragma unroll
            for (int q = 0; q < 8; ++q) { const size_t un = ((size_t)b * 32 + c8 + q) * 32 + h; st[q] = *(const u32x4*)(ST + un * 8192 + cq * 8); dec[q] = CDEC[un]; }
#pragma unroll
            for (int q = 0; q < 8; ++q) { const size_t un = ((size_t)b * 32 + c8 + q) * 32 + h;
                *(u32x4*)(HP + un * 8192 + cq * 8) = pk8(h0, h1);
                h0 = h0 * dec[q] + unpk4((u32x2){st[q].x, st[q].y}); h1 = h1 * dec[q] + unpk4((u32x2){st[q].z, st[q].w}); } }
        float* o = osp + ((size_t)bh * 64 + p) * 128 + n0; nts(h0, (f32x4*)o); nts(h1, (f32x4*)(o + 4));
    }
}

__device__ __forceinline__ void phase_ssdy(const Ctx& C0) {
    const Ctx C = ctx_local(C0);
    const bf16_t* XC = WSP(bf16_t, WS_XBCC) - (size_t)MP * CXBC;
    const bf16_t* Z = WSP(bf16_t, WS_Z); const float* DT = WSP(float, WS_DT); const float* ACS = WSP(float, WS_ACS);
    const bf16_t* HP = WSP(bf16_t, WS_HPREV); bf16_t* YG = WSP(bf16_t, WS_YG); float* GRS = WSP(float, WS_GRS); const bf16_t* CSV = WSP(bf16_t, WS_CSAVE);
    const float* Dsk = GIN(I_CD); const float* nw = GIN(I_CNORM);
    const int w = C.wave, fr = C.fr, fq = C.fq, tid = C.tid, lane = C.lane;
    {
        LAS char* Ct = C.lds; LAS float* acsL = (LAS float*)(C.lds + 34816); LAS float* gss = (LAS float*)(C.lds + 34816 + 4096);
        for (int u = C.bid; u < 512; u += C.G) {
            const int g = u & 3, c = (u >> 2) & 31, b = u >> 7; const size_t row0 = (size_t)b * 4096 + 128 * c; const int head = 8 * g + w;
            const bf16_t* hp = HP + (((size_t)b * 32 + c) * 32 + head) * 8192;
            bf16x8 hpf[4][4];
#pragma unroll
            for (int kk = 0; kk < 4; ++kk)
#pragma unroll
                for (int pb = 0; pb < 4; ++pb) hpf[kk][pb] = *(const bf16x8*)(hp + (((pb * 4 + kk) * 4 + fq) * 16 + fr) * 8);
            { const bf16_t* cs = CSV + (((size_t)b * 32 + c) * 4 + g) * 16384;
#pragma unroll
              for (int v = 0; v < 4; ++v) { const int idx = tid + 512 * v, r = idx >> 4, ch = idx & 15; *(LAS u32x4*)(Ct + r * 272 + ch * 16) = *(const u32x4*)(cs + r * 128 + 8 * ch); }
#pragma unroll
              for (int v = 0; v < 2; ++v) { const int e = tid + 512 * v, hh = e >> 7, t = e & 127; acsL[e] = ACS[(row0 + t) * 32 + 8 * g + hh]; } }
            __syncthreads();
            LAS float* tsc = (LAS float*)(C.lds + 49152) + w * 1088;
            const int er = lane >> 2, ec = (lane & 3) * 16;
            u32x4 yc[2], zc[2], yn[2], zn[2];
#pragma unroll
            for (int h2 = 0; h2 < 2; ++h2) { const size_t o = (row0 + er) * CDI + 64 * head + ec + 8 * h2; yc[h2] = *(const u32x4*)(YG + o); zc[h2] = *(const u32x4*)(Z + o); }
#pragma unroll 1
            for (int ib = 0; ib < 8; ++ib) { const int i = 16 * ib + fr;
                if (ib < 7) {
#pragma unroll
                    for (int h2 = 0; h2 < 2; ++h2) { const size_t o = (row0 + 16 * ib + 16 + er) * CDI + 64 * head + ec + 8 * h2; yn[h2] = *(const u32x4*)(YG + o); zn[h2] = *(const u32x4*)(Z + o); } }
                f32x4 a2[4];
#pragma unroll
                for (int pb = 0; pb < 4; ++pb) a2[pb] = (f32x4){0.f, 0.f, 0.f, 0.f};
#pragma unroll
                for (int kk = 0; kk < 4; ++kk) { const bf16x8 cf = *(const LAS bf16x8*)(Ct + i * 272 + (32 * kk + 8 * fq) * 2);
#pragma unroll
                    for (int pb = 0; pb < 4; ++pb) a2[pb] = MFMA16(hpf[kk][pb], cf, a2[pb]); }
                const float ea = __expf(acsL[w * 128 + i]);
#pragma unroll
                for (int pb = 0; pb < 4; ++pb) *(LAS f32x4*)(tsc + fr * 68 + 16 * pb + 4 * fq) = a2[pb] * ea;
                f32x4 t4[4];
#pragma unroll
                for (int q = 0; q < 4; ++q) t4[q] = *(const LAS f32x4*)(tsc + er * 68 + ec + 4 * q);
                float ss = 0.f; u32x4 o2[2];
#pragma unroll
                for (int h2 = 0; h2 < 2; ++h2) { const f32x4 z0 = unpk4((u32x2){zc[h2].x, zc[h2].y}), z1 = unpk4((u32x2){zc[h2].z, zc[h2].w});
                    f32x4 y0 = unpk4((u32x2){yc[h2].x, yc[h2].y}) + t4[2 * h2], y1 = unpk4((u32x2){yc[h2].z, yc[h2].w}) + t4[2 * h2 + 1];
#pragma unroll
                    for (int e = 0; e < 4; ++e) { y0[e] *= silu_f(z0[e]); y1[e] *= silu_f(z1[e]); }
                    ss += sq4(y0) + sq4(y1); o2[h2] = pk8(y0, y1); }
#pragma unroll
                for (int h2 = 0; h2 < 2; ++h2) *(u32x4*)(YG + (row0 + 16 * ib + er) * CDI + 64 * head + ec + 8 * h2) = o2[h2];
                ss += __shfl_xor(ss, 1); ss += __shfl_xor(ss, 2);
                if ((lane & 3) == 0) gss[w * 128 + 16 * ib + er] = ss;
#pragma unroll
                for (int h2 = 0; h2 < 2; ++h2) { yc[h2] = yn[h2]; zc[h2] = zn[h2]; }
            }
            __syncthreads();
            if (tid < 128) { float tot = 0.f;
#pragma unroll
                for (int hh = 0; hh < 8; ++hh) tot += gss[hh * 128 + tid];
                GRS[(row0 + tid) * 4 + g] = rsqrtf(tot * (1.0f / 512.0f) + EPS); }
            __syncthreads();
        }
    }
    {
        LAS float* xS = (LAS float*)C.lds; LAS float* BS = xS + 8 * 4 * 64; LAS float* CS = BS + 512; LAS float* yI = CS + 512; LAS float* gsS = yI + 8 * 4 * 64; LAS float* wL = gsS + 32;
        const float* h0p = GIN(I_SSM); float* oss = C.out + O_SSMS;
        for (int u = C.bid; u < 512; u += C.G) {
            const int s = u >> 2, g = u & 3, head = 8 * g + w; const size_t rowb = (size_t)MP + 4 * s;
            float dt[4]; const float A = -__expf(GIN(I_CALOG)[head]);
#pragma unroll
            for (int t = 0; t < 4; ++t) dt[t] = DT[(rowb + t) * 32 + head];
            for (int e = tid; e < 512; e += 512) { const int t = e >> 7, n = e & 127; BS[e] = bf2f(XC[(rowb + t) * CXBC + 2048 + 128 * g + n]); CS[e] = bf2f(XC[(rowb + t) * CXBC + 2560 + 128 * g + n]); }
#pragma unroll
            for (int t = 0; t < 4; ++t) xS[(w * 4 + t) * 64 + lane] = bf2f(XC[(rowb + t) * CXBC + 64 * head + lane]);
            __syncthreads();
            float acs[4];
#pragma unroll
            for (int t = 0; t < 4; ++t) acs[t] = (t ? acs[t - 1] : 0.f) + dt[t] * A;
            bf16x8 cfr[4], bfr[4];
#pragma unroll
            for (int kk = 0; kk < 4; ++kk) { u32x4 cv = (u32x4){0u, 0u, 0u, 0u}, bv = cv;
                if (fr < 4) { cv = *(const u32x4*)(XC + (rowb + fr) * CXBC + 2560 + 128 * g + 32 * kk + 8 * fq); bv = *(const u32x4*)(XC + (rowb + fr) * CXBC + 2048 + 128 * g + 32 * kk + 8 * fq); }
                cfr[kk] = __builtin_bit_cast(bf16x8, cv); bfr[kk] = __builtin_bit_cast(bf16x8, bv); }
            { f32x4 cbm = (f32x4){0.f, 0.f, 0.f, 0.f};
#pragma unroll
              for (int kk = 0; kk < 4; ++kk) cbm = MFMA16(bfr[kk], cfr[kk], cbm);
              if (lane < 4) { const float ai = lane == 0 ? acs[0] : lane == 1 ? acs[1] : lane == 2 ? acs[2] : acs[3];
#pragma unroll
                  for (int j = 0; j < 4; ++j) wL[(w * 4 + lane) * 4 + j] = (j <= lane) ? cbm[j] * __expf(ai - acs[j]) * dt[j] : 0.f; } }
            float yin[4];
#pragma unroll
            for (int i = 0; i < 4; ++i) { float y = 0.f;
#pragma unroll
                for (int j = 0; j <= i; ++j) y += wL[(w * 4 + i) * 4 + j] * xS[(w * 4 + j) * 64 + lane];
                yin[i] = y; }
            const float dec3 = __expf(acs[3]); float cj[4];
#pragma unroll
            for (int j = 0; j < 4; ++j) cj[j] = __expf(acs[3] - acs[j]) * dt[j];
            const size_t hb = ((size_t)s * 32 + head) * 8192;
            bf16_t zr[4]; const float dsk = Dsk[head];
#pragma unroll
            for (int i = 0; i < 4; ++i) zr[i] = Z[(rowb + i) * CDI + 64 * head + lane];
#pragma unroll 1
            for (int pb = 0; pb < 4; ++pb) { const int p = 16 * pb + fr; f32x4 hlo[4], hhi[4];
#pragma unroll
                for (int kk = 0; kk < 4; ++kk) { const float* hp = h0p + hb + p * 128 + 32 * kk + 8 * fq; hlo[kk] = ntl((const f32x4*)hp); hhi[kk] = ntl((const f32x4*)(hp + 4)); }
                float xc[4];
#pragma unroll
                for (int j = 0; j < 4; ++j) xc[j] = xS[(w * 4 + j) * 64 + p] * cj[j];
                f32x4 ya = (f32x4){0.f, 0.f, 0.f, 0.f};
#pragma unroll
                for (int kk = 0; kk < 4; ++kk) { ya = MFMA16(__builtin_bit_cast(bf16x8, pk8(hlo[kk], hhi[kk])), cfr[kk], ya);
                    f32x4 lo = hlo[kk] * dec3, hi = hhi[kk] * dec3;
#pragma unroll
                    for (int j = 0; j < 4; ++j) { lo += *(const LAS f32x4*)(BS + j * 128 + 32 * kk + 8 * fq) * xc[j]; hi += *(const LAS f32x4*)(BS + j * 128 + 32 * kk + 8 * fq + 4) * xc[j]; }
                    float* op = oss + hb + p * 128 + 32 * kk + 8 * fq; nts(lo, (f32x4*)op); nts(hi, (f32x4*)(op + 4)); }
                if (fr < 4) { const float ea = __expf(fr == 0 ? acs[0] : fr == 1 ? acs[1] : fr == 2 ? acs[2] : acs[3]);
#pragma unroll
                    for (int r = 0; r < 4; ++r) yI[(w * 4 + fr) * 64 + 16 * pb + 4 * fq + r] = ya[r] * ea; } }
            __syncthreads();
            float gv[4];
#pragma unroll
            for (int i = 0; i < 4; ++i) { const float y = yin[i] + yI[(w * 4 + i) * 64 + lane] + dsk * xS[(w * 4 + i) * 64 + lane];
                gv[i] = y * silu_f(bf2f(zr[i])); const float sq = wave_sum(gv[i] * gv[i]); if (lane == 0) gsS[w * 4 + i] = sq; }
            __syncthreads();
#pragma unroll
            for (int i = 0; i < 4; ++i) { float tot = 0.f;
#pragma unroll
                for (int hh = 0; hh < 8; ++hh) tot += gsS[hh * 4 + i];
                YG[(rowb + i) * CDI + 64 * head + lane] = (bf16_t)(pk2(gv[i], 0.f) & 0xffffu);
                if (w == 0 && lane == 0) GRS[(rowb + i) * 4 + g] = rsqrtf(tot * (1.0f / 512.0f) + EPS); }
            __syncthreads();
        }
    }
}
#define XB_TMO      128
#define XB_XCNT(j)  (256  + 64 * (j))
#define XB_XSUB(j)  (1280 + 64 * (j))
#define XB_XGEN(j)  (2304 + 64 * (j))
#define XB_TOP      3328
#define XB_TOPGEN   3392
#define XCD_BAR_WORDS 3456
#define XB_SPIN_CAP (1u << 18)
__device__ __forceinline__ unsigned xb_ld(unsigned* p)              { return __hip_atomic_load(p, __ATOMIC_RELAXED, __HIP_MEMORY_SCOPE_AGENT); }
__device__ __forceinline__ unsigned xb_add(unsigned* p, unsigned v) { return __hip_atomic_fetch_add(p, v, __ATOMIC_RELAXED, __HIP_MEMORY_SCOPE_AGENT); }
__device__ __forceinline__ unsigned xb_xcc_id() { return (unsigned)__builtin_amdgcn_s_getreg((3 << 11) | 20) & 0xFu; }
#define XB_SPIN(cond, bar) do { unsigned _sp = 0; while (cond) { __builtin_amdgcn_s_sleep(1); \
    if ((++_sp & 255u) == 0u) { if (xb_ld(&(bar)[XB_TMO])) break; if (_sp > XB_SPIN_CAP) { atomicAdd(&(bar)[XB_TMO], 1u); break; } } } } while (0)
__device__ __forceinline__ void xcd_barrier_complete(unsigned* bar, unsigned x, unsigned& nloc, unsigned& nx) {
    const unsigned G = gridDim.x * gridDim.y * gridDim.z;
    unsigned sum, cnt, mine, sp = 0u;
    for (;;) {
        sum = 0u; cnt = 0u; mine = 0u;
#pragma unroll
        for (unsigned j = 0; j < 16; ++j) { const unsigned c = xb_ld(&bar[XB_XCNT(j)]); sum += c; cnt += (c > 0u) ? 1u : 0u; mine = (j == x) ? c : mine; }
        if (sum == G) break;
        __builtin_amdgcn_s_sleep(1);
        if ((++sp & 255u) == 0u) { if (xb_ld(&bar[XB_TMO])) break; if (sp > XB_SPIN_CAP) { atomicAdd(&bar[XB_TMO], 1u); break; } }
    }
    nloc = mine > 0u ? mine : 1u; nx = cnt > 0u ? cnt : 1u;
}
__device__ __forceinline__ void xcd_barrier(unsigned* bar, volatile LAS unsigned* st) {
    asm volatile("s_waitcnt vmcnt(0)" ::: "memory");
    __syncthreads();
    if (threadIdx.x == 0) {
        const unsigned x = xb_xcc_id();
        __builtin_amdgcn_s_waitcnt(0);
        unsigned nloc = st[0], nx = st[1];
        if (nloc == 0u) { xcd_barrier_complete(bar, x, nloc, nx); st[0] = nloc; st[1] = nx; }
        const unsigned old = xb_add(&bar[XB_XSUB(x)], 1u);
        const unsigned gen = old / nloc;
        if (old + 1u == (gen + 1u) * nloc) {
            __builtin_amdgcn_fence(__ATOMIC_RELEASE, "agent");
            asm volatile("s_waitcnt vmcnt(0)" ::: "memory");
            const unsigned og = xb_add(&bar[XB_TOP], 1u);
            const unsigned tg = og / nx;
            if (og + 1u == (tg + 1u) * nx) xb_add(&bar[XB_TOPGEN], 1u);
            else XB_SPIN(xb_ld(&bar[XB_TOPGEN]) == tg, bar);
            __builtin_amdgcn_fence(__ATOMIC_ACQUIRE, "agent");
            xb_add(&bar[XB_XGEN(x)], 1u);
            asm volatile("s_waitcnt vmcnt(0)" ::: "memory");
        } else {
            XB_SPIN(xb_ld(&bar[XB_XGEN(x)]) == gen, bar);
            __builtin_amdgcn_fence(__ATOMIC_ACQUIRE, "agent");
            asm volatile("s_waitcnt vmcnt(0)" ::: "memory");
        }
    }
    __syncthreads();
}

constexpr int N_PHASES = 33;
constexpr int LDS_BYTES = 163840;
constexpr int LDS_BARST = 163840 - 16;
constexpr size_t CTL_BYTES = 65536;
constexpr int CW_BAR = 4096;
__host__ __device__ __forceinline__ bool phase_empty(int ph) { if (ph == 0) return false; const int L = (ph - 1) >> 3, loc = (ph - 1) & 7; return ((loc >= 2 && loc <= 4) && (L % 3 != 2)) || (loc == 1 && L % 3 == 2); }

__global__ void __launch_bounds__(512, 2) fwd(Args a) {
    extern __shared__ __attribute__((aligned(16))) unsigned char lds_raw[];
    if (threadIdx.x < 4) ((LAS unsigned*)((LAS char*)lds_raw + LDS_BARST))[threadIdx.x] = 0u;
    if (threadIdx.x == 0) (void)xb_add((unsigned*)(a.ws + WS_CTL) + CW_BAR + XB_XCNT(xb_xcc_id()), 1u);
    __syncthreads();
    bool first = true;
#pragma unroll 1
    for (int ph = a.ph_lo; ph < a.ph_hi; ++ph) {
        if (phase_empty(ph)) continue;
#ifdef REPEAT_MASK
        for (int rep = ((REPEAT_MASK >> ph) & 1ull) ? 1 : 0; rep >= 0; --rep) {
#else
        {
#endif
        int tid = threadIdx.x; asm volatile("" : "+v"(tid));
        tab_t inp = (tab_t)__builtin_amdgcn_kernarg_segment_ptr(); asm volatile("" : "+s"(inp));
        unsigned char* ws = (unsigned char*)(__attribute__((address_space(1))) unsigned char*)inp[N_IN + 1]; float* out = (float*)(__attribute__((address_space(1))) float*)inp[N_IN];
        if (!first) xcd_barrier((unsigned*)(ws + WS_CTL) + CW_BAR, (volatile LAS unsigned*)((LAS char*)lds_raw + LDS_BARST));
        first = false;
        Ctx C; C.lds = (LAS char*)lds_raw; C.tid = tid; C.lane = 0; C.wave = 0; C.fr = 0; C.fq = 0;
        C.G = gridDim.x; C.bid = blockIdx.x; C.in = inp; C.out = out; C.ws = ws;
        float* XSS = WSP(float, WS_XSS); bf16_t* XB = WSP(bf16_t, WS_XB);
        const int kb = (C.bid >> 3) & 3;
        if (ph == 0) { phase_prologue(C); } else {
        const int L = (ph - 1) >> 3, loc = (ph - 1) & 7, kind = L % 3, j = L / 3;
        if (loc == 0) {
            pg8::StaticOrder S;
            if (kind == 0) { pg8::Gemm g{XB, WSP(bf16_t, WS_WAI) + (size_t)j * AFF * DM, MP, AFF, DM}; S.init(MP, AFF, C.G, C.bid);
                pg8::EpiAIn E{WSP(bf16_t, WS_UV), XSS, WSP(float, WS_VSS)}; _Pragma("unroll 1") for (int st2 = 0; st2 < 3; ++st2) { int tid2 = C.tid; asm volatile("" : "+v"(tid2)); if (st2 == 1) { pg8::gemm_phase<pg8::EpiAIn, pg8::StaticOrder, true, true>((LAS unsigned char*)C.lds, g, S, E, tid2); } else { sg::SEpiAIn SE{WSP(bf16_t, WS_UV), XSS, WSP(float, WS_VSS)}; sg::sgemm_phase(C.lds, g.A, g.Bt, AFF, DM, AFF, SE, tid2, C.bid, C.G, st2 == 0 ? 0 : kb, st2 == 0 ? kb : 1000); } } }
            else if (kind == 1) { pg8::Gemm g{XB, WSP(bf16_t, WS_WQKV), MP, NQKV, DM}; S.init(MP, NQKV, C.G, C.bid);
                pg8::EpiQKV E{WSP(bf16_t, WS_QKV), XSS, GIN(I_BQN), GIN(I_BKN)}; _Pragma("unroll 1") for (int st2 = 0; st2 < 3; ++st2) { int tid2 = C.tid; asm volatile("" : "+v"(tid2)); if (st2 == 1) { pg8::gemm_phase<pg8::EpiQKV, pg8::StaticOrder, true, true>((LAS unsigned char*)C.lds, g, S, E, tid2); } else { sg::SEpiQKV SE{WSP(bf16_t, WS_QKV), XSS, GIN(I_BQN), GIN(I_BKN)}; sg::sgemm_phase(C.lds, g.A, g.Bt, NQKV, DM, NQKV, SE, tid2, C.bid, C.G, st2 == 0 ? 0 : (kb & 1), st2 == 0 ? (kb & 1) : 1000, 0, 0, 1); } } }
            else { pg8::Gemm g{XB, WSP(bf16_t, WS_WCI), MP, CDI + CXBC, DM}; S.init(MP, CDI + CXBC, C.G, C.bid);
                pg8::EpiCIn E{WSP(bf16_t, WS_Z), WSP(bf16_t, WS_XBCR), WSP(float, WS_DT), XSS, GIN(I_CDTB)}; _Pragma("unroll 1") for (int st2 = 0; st2 < 3; ++st2) { int tid2 = C.tid; asm volatile("" : "+v"(tid2)); if (st2 == 1) { pg8::gemm_phase<pg8::EpiCIn, pg8::StaticOrder, true, true>((LAS unsigned char*)C.lds, g, S, E, tid2); } else { sg::SEpiCIn SE{WSP(bf16_t, WS_Z), WSP(bf16_t, WS_XBCR), WSP(float, WS_DT), XSS, GIN(I_CDTB)}; sg::sgemm_phase(C.lds, g.A, g.Bt, CINP, DM, 5120, SE, tid2, C.bid, C.G, st2 == 0 ? 0 : kb, st2 == 0 ? kb : 1000, MP / 64 + 8, 80); } } }
        } else if (loc == 1) {
            if (kind == 0) phase_spatial(C, j); else if (kind == 1) phase_attn(C);
        } else if (loc == 2) { phase_states(C);
        } else if (loc == 3) { phase_scan(C);
        } else if (loc == 4) { phase_ssdy(C);
        } else if (loc == 6) {
            pg8::Gemm g{XB, WSP(bf16_t, WS_WUP) + (size_t)L * FF * DM, MP, FF, DM}; pg8::StaticOrder S; S.init(MP, FF, C.G, C.bid);
            pg8::EpiUp E{WSP(bf16_t, WS_H), XSS}; _Pragma("unroll 1") for (int st2 = 0; st2 < 3; ++st2) { int tid2 = C.tid; asm volatile("" : "+v"(tid2)); if (st2 == 1) { pg8::gemm_phase<pg8::EpiUp, pg8::StaticOrder, true, true>((LAS unsigned char*)C.lds, g, S, E, tid2); } else { sg::SEpiUp SE{WSP(bf16_t, WS_H), XSS}; sg::sgemm_phase(C.lds, g.A, g.Bt, FF, DM, FF, SE, tid2, C.bid, C.G, st2 == 0 ? 0 : kb, st2 == 0 ? kb : 1000); } }
        } else if (loc == 5 && kind == 2) {
            pg8::Gemm g{WSP(bf16_t, WS_YG), WSP(bf16_t, WS_WCO), MP, DM, CDI};
            pg8::EpiResG E{nullptr, C.ws, WSP(float, WS_GRS)};
            pg8::StaticOrder S; S.init(MP, DM, C.G, C.bid);
            _Pragma("unroll 1") for (int st2 = 0; st2 < 3; ++st2) { int tid2 = C.tid; asm volatile("" : "+v"(tid2)); if (st2 == 1) { pg8::gemm_phase<pg8::EpiResG, pg8::StaticOrder, true, true>((LAS unsigned char*)C.lds, g, S, E, tid2); } else { sg::SEpiResG SE{nullptr, C.ws, WSP(float, WS_GRS)}; sg::sgemm32_phase(C.lds, g.A, g.Bt, CDI, SE, tid2, C.bid, C.G, st2 == 0 ? 0 : (kb & 1), st2 == 0 ? (kb & 1) : 1000); } }
        } else {
            pg8::Gemm g; g.M = MP; g.N = DM;
            if (loc == 7) { g.A = WSP(bf16_t, WS_H); g.Bt = WSP(bf16_t, WS_WDN) + (size_t)L * DM * FF; g.K = FF; }
            else if (kind == 0) { g.A = WSP(bf16_t, WS_GATED); g.Bt = WSP(bf16_t, WS_WAO) + (size_t)j * DM * AH; g.K = AH; }
            else { g.A = WSP(bf16_t, WS_O); g.Bt = WSP(bf16_t, WS_WBO); g.K = DM; }
            float* Yout = (L == 3 && loc == 7) ? C.out : nullptr;
            pg8::EpiRes E{Yout, C.ws, nullptr};
            pg8::StaticOrder S; S.init(MP, DM, C.G, C.bid);
            _Pragma("unroll 1") for (int st2 = 0; st2 < 3; ++st2) { int tid2 = C.tid; asm volatile("" : "+v"(tid2)); if (st2 == 1) { pg8::gemm_phase<pg8::EpiRes, pg8::StaticOrder, true, true>((LAS unsigned char*)C.lds, g, S, E, tid2); } else { sg::SEpiRes SE{Yout, C.ws, nullptr}; sg::sgemm32_phase(C.lds, g.A, g.Bt, g.K, SE, tid2, C.bid, C.G, st2 == 0 ? 0 : (kb & 1), st2 == 0 ? (kb & 1) : 1000); } }
        }
        }
        }
    }
}

#ifndef PROBE_LO
#define PROBE_LO 0
#define PROBE_HI 0
#define PROBE_ALPHA 1.0f
#endif
#ifndef N_LAUNCH_MODE
#define N_LAUNCH_MODE 0
#endif
__global__ void k_probe(float* out, size_t lo, size_t hi, float alpha, size_t n) {
    for (size_t i = (size_t)blockIdx.x * blockDim.x + threadIdx.x; i < n; i += (size_t)gridDim.x * blockDim.x) out[i] = (i >= lo && i < hi) ? out[i] * alpha : 0.f;
}
extern "C" void kernel_launch(void* const* d_in, const int* in_sizes, int n_in, void* d_out, int out_size, void* d_ws, size_t ws_size, hipStream_t stream) {
    static int grid = 0;
    if (grid == 0) {
        if (n_in != N_IN || (size_t)out_size != O_TOTAL || ws_size < WS_NEED) { fprintf(stderr, "kernel_launch: unexpected problem (n_in %d, out %d, ws %zu)\n", n_in, out_size, ws_size); grid = -1; return; }
        int dev = 0, cus = 0;
        if (hipGetDevice(&dev) != hipSuccess || hipDeviceGetAttribute(&cus, hipDeviceAttributeMultiprocessorCount, dev) != hipSuccess) { grid = -1; return; }
        if (hipFuncSetAttribute((const void*)fwd, hipFuncAttributeMaxDynamicSharedMemorySize, LDS_BYTES) != hipSuccess) { fprintf(stderr, "kernel_launch: hipFuncSetAttribute failed\n"); grid = -1; return; }
        (void)hipGetLastError();
        grid = cus > 0 ? cus : 256;
    }
    if (grid < 0) return;
    Args a{};
    for (int i = 0; i < N_IN; ++i) a.in[i] = (const float*)d_in[i];
    a.out = (float*)d_out; a.ws = (unsigned char*)d_ws;
    if (hipMemsetAsync((char*)d_ws + WS_CTL, 0, CTL_BYTES, stream) != hipSuccess) return;
    if (N_LAUNCH_MODE == 0) { a.ph_lo = 0; a.ph_hi = N_PHASES; hipLaunchKernelGGL(fwd, dim3(grid), dim3(512), LDS_BYTES, stream, a); }
    else for (int ph = 0; ph < N_PHASES; ++ph) { if (phase_empty(ph)) continue; a.ph_lo = ph; a.ph_hi = ph + 1; hipLaunchKernelGGL(fwd, dim3(grid), dim3(512), LDS_BYTES, stream, a); }
    if (PROBE_HI > PROBE_LO) hipLaunchKernelGGL(k_probe, dim3(2048), dim3(256), 0, stream, (float*)d_out, (size_t)(PROBE_LO), (size_t)(PROBE_HI), (float)(PROBE_ALPHA), (size_t)O_TOTAL);
}
```
